# Optimizing an MI355X kernel written in HIP

```python
import jax, jax.numpy as jnp
from jax import lax
import numpy as np

D_MODEL = 2048
BATCH = 2
SEQ = 8192
DEPTH = 1

MEM_LEN = 256
HEAD_DIM = 128
D_MIX = D_MODEL
N_MOBA_HEADS = D_MIX // 2 // HEAD_DIM
MOBA_WIDTH = N_MOBA_HEADS * HEAD_DIM
N_MEM_HEADS = 4
MEM_WIDTH = N_MEM_HEADS * HEAD_DIM
POOL_WIDTH = D_MIX - MOBA_WIDTH - MEM_WIDTH
POOL_WINDOWS = (2, 4, 8, 16)
N_POOL_GROUPS = len(POOL_WINDOWS)
POOL_GROUP_DIM = POOL_WIDTH // N_POOL_GROUPS
MOBA_BLOCK = 256
MOBA_TOPK = 3
QUERY_CHUNK = 32
EPS = 1e-6
IN_SIZES = (MOBA_WIDTH, MOBA_WIDTH, MOBA_WIDTH, MOBA_WIDTH,
            POOL_WIDTH, POOL_WIDTH,
            MEM_WIDTH, MEM_WIDTH)
D_IN = sum(IN_SIZES)
IN_OFFSETS = [int(o) for o in np.cumsum(IN_SIZES)[:-1]]

kernel_name = "hybrid_moba_pool_memory_layer"


def rmsnorm(x, g):
    xf = x.astype(jnp.float32)
    y = xf * lax.rsqrt(jnp.mean(xf * xf, axis=-1, keepdims=True) + EPS)
    return (y * g.astype(jnp.float32)).astype(x.dtype)


def moba_attention(q, k, v):
    B, S, H, Dh = q.shape
    nb = -(-S // MOBA_BLOCK)
    s_pad = nb * MOBA_BLOCK
    pad = ((0, 0), (0, 0), (0, s_pad - S), (0, 0))
    q = jnp.pad(q.transpose(0, 2, 1, 3), pad)
    k = jnp.pad(k.transpose(0, 2, 1, 3), pad)
    v = jnp.pad(v.transpose(0, 2, 1, 3), pad)
    k_blk = k.reshape(B, H, nb, MOBA_BLOCK, Dh)
    v_blk = v.reshape(B, H, nb, MOBA_BLOCK, Dh)
    k_mean = jnp.mean(k_blk.astype(jnp.float32), axis=3)
    n_chunks = s_pad // QUERY_CHUNK
    q_chunks = q.reshape(B, H, n_chunks, QUERY_CHUNK, Dh).transpose(2, 0, 1, 3, 4)
    topk = min(MOBA_TOPK, nb - 1)
    scale = Dh ** -0.5
    b_ix = jnp.arange(B)[:, None, None, None]
    h_ix = jnp.arange(H)[None, :, None, None]
    blk_ids = jnp.arange(nb)

    def chunk(args):
        qc, c = args
        start = c * QUERY_CHUNK
        blk = start // MOBA_BLOCK
        qpos = start + jnp.arange(QUERY_CHUNK)
        kpos = blk * MOBA_BLOCK + jnp.arange(MOBA_BLOCK)
        k_own = lax.dynamic_index_in_dim(k_blk, blk, axis=2, keepdims=False)
        v_own = lax.dynamic_index_in_dim(v_blk, blk, axis=2, keepdims=False)
        s_own = jnp.einsum('bhqd,bhkd->bhqk', qc, k_own).astype(jnp.float32) * scale
        s_own = jnp.where(kpos[None, :] <= qpos[:, None], s_own, -jnp.inf)
        if topk == 0:
            p = jax.nn.softmax(s_own, axis=-1).astype(v.dtype)
            return jnp.einsum('bhqk,bhkd->bhqd', p, v_own)
        gate = jnp.einsum('bhqd,bhnd->bhqn', qc.astype(jnp.float32), k_mean)
        gate = jnp.where(blk_ids < blk, gate, -jnp.inf)
        _, idx = lax.top_k(gate, topk)
        valid = idx < blk
        k_sel = k_blk[b_ix, h_ix, idx]
        v_sel = v_blk[b_ix, h_ix, idx]
        s_sel = jnp.einsum('bhqd,bhqnkd->bhqnk', qc, k_sel).astype(jnp.float32) * scale
        s_sel = jnp.where(valid[..., None], s_sel, -jnp.inf)
        s_sel = s_sel.reshape(B, H, QUERY_CHUNK, topk * MOBA_BLOCK)
        p = jax.nn.softmax(jnp.concatenate([s_sel, s_own], axis=-1), axis=-1).astype(v.dtype)
        p_sel = p[..., :topk * MOBA_BLOCK].reshape(B, H, QUERY_CHUNK, topk, MOBA_BLOCK)
        p_own = p[..., topk * MOBA_BLOCK:]
        return (jnp.einsum('bhqnk,bhqnkd->bhqd', p_sel, v_sel)
                + jnp.einsum('bhqk,bhkd->bhqd', p_own, v_own))

    out = lax.map(chunk, (q_chunks, jnp.arange(n_chunks)))
    out = out.transpose(1, 0, 3, 2, 4).reshape(B, s_pad, H, Dh)
    return out[:, :S]


def multiscale_pool(u, w_pool, pool_scale):
    B, S, _ = u.shape
    uf = u.astype(jnp.float32)
    cs = jnp.cumsum(uf, axis=1)
    t = jnp.arange(S)
    outs = []
    for g, w in enumerate(POOL_WINDOWS):
        csg = cs[..., g * POOL_GROUP_DIM:(g + 1) * POOL_GROUP_DIM]
        prev = jnp.pad(csg, ((0, 0), (w, 0), (0, 0)))[:, :S]
        cnt = jnp.minimum(t + 1, w).astype(jnp.float32)[None, :, None]
        outs.append((csg - prev) / cnt)
    pooled = jnp.stack(outs, axis=2) - uf.reshape(B, S, N_POOL_GROUPS, POOL_GROUP_DIM)
    mixed = jnp.einsum('bsgc,gcd->bsgd', pooled.astype(u.dtype), w_pool)
    return mixed.reshape(B, S, POOL_WIDTH) * pool_scale


def memory_attention(q, mem_k, mem_v):
    s = jnp.einsum('bshd,bmhd->bhsm', q, mem_k).astype(jnp.float32) * (HEAD_DIM ** -0.5)
    p = jax.nn.softmax(s, axis=-1).astype(mem_v.dtype)
    return jnp.einsum('bhsm,bmhd->bshd', p, mem_v)


def hybrid_layer(x, mem, norm_g, mem_norm_g, w_in, w_mem_kv, w_pool, pool_scale, w_out):
    B, S, _ = x.shape
    h = rmsnorm(x, norm_g)
    z = h @ w_in
    q_a, k_a, v_a, g_a, u_p, g_p, q_m, g_m = jnp.split(z, IN_OFFSETS, axis=-1)
    hd = (B, S, N_MOBA_HEADS, HEAD_DIM)
    y_a = moba_attention(q_a.reshape(hd), k_a.reshape(hd), v_a.reshape(hd))
    y_a = y_a.reshape(B, S, MOBA_WIDTH) * jax.nn.silu(g_a)
    y_p = multiscale_pool(u_p, w_pool, pool_scale) * jax.nn.silu(g_p)
    mem_h = rmsnorm(mem, mem_norm_g)
    mk, mv = jnp.split(mem_h @ w_mem_kv, 2, axis=-1)
    M = mem.shape[1]
    y_m = memory_attention(q_m.reshape(B, S, N_MEM_HEADS, HEAD_DIM),
                           mk.reshape(B, M, N_MEM_HEADS, HEAD_DIM),
                           mv.reshape(B, M, N_MEM_HEADS, HEAD_DIM))
    y_m = y_m.reshape(B, S, MEM_WIDTH) * jax.nn.silu(g_m)
    y = jnp.concatenate([y_a, y_p, y_m], axis=-1) @ w_out
    return x + y


def setup_inputs(seed: int = 0) -> dict:
    key = jax.random.key(seed)
    ks = jax.random.split(key, 11)
    f32 = jnp.float32
    x = jax.random.normal(ks[0], (BATCH, SEQ, D_MODEL), f32)
    mem = jax.random.normal(ks[1], (BATCH, MEM_LEN, D_MODEL), f32)
    norm_g = 1.0 + 0.02 * jax.random.normal(ks[2], (DEPTH, D_MODEL), f32)
    mem_norm_g = 1.0 + 0.02 * jax.random.normal(ks[3], (DEPTH, D_MODEL), f32)
    w_in = jax.random.normal(ks[4], (DEPTH, D_MODEL, D_IN), f32) * D_MODEL ** -0.5
    w_mem_kv = jax.random.normal(ks[5], (DEPTH, D_MODEL, 2 * MEM_WIDTH), f32) * D_MODEL ** -0.5
    w_pool = jax.random.normal(ks[6], (DEPTH, N_POOL_GROUPS, POOL_GROUP_DIM, POOL_GROUP_DIM), f32) * POOL_GROUP_DIM ** -0.5
    pool_scale = 1.0 + 0.1 * jax.random.normal(ks[7], (DEPTH, POOL_WIDTH), f32)
    w_out = jax.random.normal(ks[8], (DEPTH, D_MIX, D_MODEL), f32) * D_MIX ** -0.5
    final_norm_g = 1.0 + 0.02 * jax.random.normal(ks[9], (D_MODEL,), f32)
    return {"x": x, "mem": mem, "norm_g": norm_g, "mem_norm_g": mem_norm_g,
            "w_in": w_in, "w_mem_kv": w_mem_kv, "w_pool": w_pool,
            "pool_scale": pool_scale, "w_out": w_out, "final_norm_g": final_norm_g}


def reference(x, mem, norm_g, mem_norm_g, w_in, w_mem_kv, w_pool, pool_scale, w_out, final_norm_g):
    for l in range(DEPTH):
        x = hybrid_layer(x, mem, norm_g[l], mem_norm_g[l], w_in[l], w_mem_kv[l],
                         w_pool[l], pool_scale[l], w_out[l])
    return rmsnorm(x, final_norm_g)
```

```cpp
#include <hip/hip_runtime.h>
#include <hip/hip_cooperative_groups.h>
#include <cstdio>
#include <cstdint>
namespace cg = cooperative_groups;
namespace pg8 {
#define PG8_LAS __attribute__((address_space(3)))
typedef unsigned short bf16_t;
typedef short bf16x8 __attribute__((ext_vector_type(8)));
typedef float f32x4 __attribute__((ext_vector_type(4)));
typedef unsigned u32x4 __attribute__((ext_vector_type(4)));
constexpr int BM = 256, BK = 64, HALF = 128, HTB = HALF * BK * 2  , STAGE_BYTES = 8 * HTB, NXCD = 8, WGM = 8;

__host__ __device__ __forceinline__ int lds_byte(int r, int c) { const int st = (r >> 4) * 2 + (c >> 5), rr = r & 15, cc = c & 31, ob = rr * 64 + cc * 2; return st * 1024 + (ob ^ (((ob >> 9) & 1) << 5)); }
__host__ __device__ __forceinline__ void stage_rc(int b, int& R, int& C) { const int st = b / 1024, sb = b % 1024, swz = sb ^ (((sb >> 9) & 1) << 5); R = (st >> 1) * 16 + swz / 64; C = (st & 1) * 32 + (swz % 64) / 2; }
__host__ __device__ __forceinline__ int perm32(int rho) { const int n = rho >> 4, i = rho & 15; return 8 * (i >> 2) + 4 * n + (i & 3); }

struct Unit { int pm, pn; };
struct Gemm { const bf16_t* A; const bf16_t* Bt; int M, N, K; };

struct StaticOrder {
    int nM, nN, nwg, G, c;
    __host__ __device__ void init(int M, int N, int G_, int c_) { nM = M / BM; nN = N / BM; nwg = nM * nN; G = G_; c = c_; }
    __host__ __device__ bool next(int i, Unit& u) const {
        const long L = (long)i * G + c; if (L >= nwg) return false;
        int wgid = (int)L; { const int q = nwg / NXCD, r = nwg % NXCD, xcd = wgid % NXCD, off = wgid / NXCD; wgid = (xcd < r ? xcd * (q + 1) : r * (q + 1) + (xcd - r) * q) + off; }
        const int nig = WGM * nN, gid = wgid / nig, fm = gid * WGM, gsz = (nM - fm) < WGM ? (nM - fm) : WGM;
        u.pm = fm + ((wgid % nig) % gsz); u.pn = (wgid % nig) / gsz; return true;
    }
    __device__ __forceinline__ void a_ready(const Unit&) const {}
    __device__ __forceinline__ void done(const Unit&) const {}
};

__device__ __forceinline__ unsigned cvt_pk_bf16(float lo, float hi) { unsigned r; asm volatile("v_cvt_pk_bf16_f32 %0, %1, %2" : "=v"(r) : "v"(lo), "v"(hi)); return r; }
typedef float f32x2 __attribute__((ext_vector_type(2)));
__device__ __forceinline__ f32x2 gelu_pk(f32x2 v) {
    const f32x2 av = __builtin_elementwise_abs(v), d = av * 0.2316418882f + 1.0f;
    f32x2 t; t.x = __builtin_amdgcn_rcpf(d.x); t.y = __builtin_amdgcn_rcpf(d.y);
    f32x2 q = t * 0.5307027145f + (-0.7265760135f); q = q * t + 0.7107068705f; q = q * t + (-0.142248368f); q = q * t + 0.127414796f; q = q * t;
    const f32x2 s = (v * v) * (-0.72134752044f);
    f32x2 e; e.x = __builtin_amdgcn_exp2f(s.x); e.y = __builtin_amdgcn_exp2f(s.y);
    const f32x2 m = v * (q * e), r = v - m;
    f32x2 o; o.x = v.x < 0.f ? m.x : r.x; o.y = v.y < 0.f ? m.y : r.y; return o;
}

template <int ACT  > struct EpiBf16 {
    static constexpr bool PERM = true, AFTER_DRAIN = false; static_assert(ACT == 0 || ACT == 1, "EpiBf16: ACT is 0 (none) or 1 (gelu_pk)");
    bf16_t* O; int ldc; const float* bias; int split_cols; size_t split_stride; float scale0;
    __device__ __forceinline__ void operator()(const f32x4 (&acc)[2][2][4][2], const Unit& u, int wr, int wc, int fr, int fq) const {
        const int row0 = u.pm * BM + wr * 64 + fr; int colt = u.pn * BM; bf16_t* base = O;
        float sc = 1.f; if (split_cols) { const int t = colt / split_cols; base += (size_t)t * split_stride; colt -= t * split_cols; if (t == 0) sc = scale0; }
        const int col0 = colt + wc * 32 + 8 * fq, bcol0 = u.pn * BM + wc * 32 + 8 * fq;
        f32x4 bv[2][2];
#pragma unroll
        for (int bj = 0; bj < 2; ++bj)
#pragma unroll
            for (int n = 0; n < 2; ++n) bv[bj][n] = bias ? *(const f32x4*)(bias + bcol0 + bj * HALF + 4 * n) : (f32x4){0.f, 0.f, 0.f, 0.f};
#pragma unroll
        for (int ai = 0; ai < 2; ++ai)
#pragma unroll
            for (int m = 0; m < 4; ++m) { bf16_t* rowp = base + (size_t)(row0 + ai * HALF + m * 16) * ldc + col0;
#pragma unroll
                for (int bj = 0; bj < 2; ++bj) { f32x4 v0 = acc[ai][bj][m][0] + bv[bj][0], v1 = acc[ai][bj][m][1] + bv[bj][1];
                    if (ACT == 1) { f32x2 a = gelu_pk((f32x2){v0[0], v0[1]}), b = gelu_pk((f32x2){v0[2], v0[3]}), c = gelu_pk((f32x2){v1[0], v1[1]}), d = gelu_pk((f32x2){v1[2], v1[3]});
                        v0 = (f32x4){a.x, a.y, b.x, b.y}; v1 = (f32x4){c.x, c.y, d.x, d.y}; }
                    v0 = v0 * sc; v1 = v1 * sc; u32x4 w; w.x = cvt_pk_bf16(v0[0], v0[1]); w.y = cvt_pk_bf16(v0[2], v0[3]); w.z = cvt_pk_bf16(v1[0], v1[1]); w.w = cvt_pk_bf16(v1[2], v1[3]);
                    *(u32x4*)(rowp + bj * HALF) = w; } }
    }
};
template <class Epi, class Sched, bool ALIGN_EPI = false, bool SP2 = false>
__device__ __forceinline__ void gemm_phase(PG8_LAS unsigned char* lds, const Gemm g, const Sched& S, const Epi& E) {
    const int tid = threadIdx.x, wid = __builtin_amdgcn_readfirstlane(tid >> 6), lane = tid & 63, wr = wid >> 2, wc = wid & 3, fr = lane & 15, fq = lane >> 4;
    const int K = g.K, nt = K / BK;
    unsigned voffA[2], voffB[2];
#pragma unroll
    for (int i = 0; i < 2; ++i) { int R, C; stage_rc(tid * 16 + i * 8192, R, C); const int Rb = Epi::PERM ? ((R & ~31) + perm32(R & 31)) : R;
        voffA[i] = (unsigned)(R * K + C) * 2u; voffB[i] = (unsigned)(Rb * K + C) * 2u; }
    const size_t kstep = (size_t)(BK * 2);
    const size_t hstep = (size_t)HALF * K * 2;
    const size_t tstep = 2 * hstep;
    const unsigned ldsw = (unsigned)wid * 1024u;
    const int aoff = lds_byte(wr * 64 + fr, fq * 8), boff = lds_byte(wc * 32 + fr, fq * 8);
#define PG8_SA(b, h) (((b) * 2 + (h)) * HTB)
#define PG8_SB(b, h) ((4 + (b) * 2 + (h)) * HTB)
#define PG8_STAGE(bufoff, gbase, voff) do { _Pragma("unroll") for (int _i = 0; _i < 2; ++_i) \
        __builtin_amdgcn_global_load_lds((const unsigned*)((const char*)(gbase) + (voff)[_i]), (PG8_LAS unsigned*)(lds + (bufoff) + ldsw + _i * 8192), 16, 0, 0); } while (0)
#define PG8_LDA(dst, b, h) do { _Pragma("unroll") for (int m = 0; m < 4; ++m) _Pragma("unroll") for (int k = 0; k < 2; ++k) dst[m][k] = *(const PG8_LAS bf16x8*)(lds + PG8_SA(b, h) + aoff + m * 2048 + k * 1024); } while (0)
#define PG8_LDB(dst, b, h) do { _Pragma("unroll") for (int n = 0; n < 2; ++n) _Pragma("unroll") for (int k = 0; k < 2; ++k) dst[n][k] = *(const PG8_LAS bf16x8*)(lds + PG8_SB(b, h) + boff + n * 2048 + k * 1024); } while (0)
#define PG8_MMA(ai, bj, At, Bt) do { __builtin_amdgcn_s_setprio(1); _Pragma("unroll") for (int m = 0; m < 4; ++m) _Pragma("unroll") for (int n = 0; n < 2; ++n) _Pragma("unroll") for (int k = 0; k < 2; ++k) \
        acc[ai][bj][m][n] = __builtin_amdgcn_mfma_f32_16x16x32_bf16(Bt[n][k], At[m][k], acc[ai][bj][m][n], 0, 0, 0); __builtin_amdgcn_s_setprio(0); } while (0)
#define PG8_WAIT_V(n) asm volatile("s_waitcnt vmcnt(" #n ")" ::: "memory")
#define PG8_WAIT_L(n) asm volatile("s_waitcnt lgkmcnt(" #n ")" ::: "memory")
#define PG8_BAR __builtin_amdgcn_s_barrier()
#define PG8_SCHED __builtin_amdgcn_sched_barrier(0)
    Unit cur, nxt; int ui = 0;
    if (!S.next(0, cur)) return;
    f32x4 acc[2][2][4][2];
#pragma unroll
    for (int a = 0; a < 2; ++a)
#pragma unroll
        for (int b = 0; b < 2; ++b)
#pragma unroll
            for (int m = 0; m < 4; ++m)
#pragma unroll
                for (int n = 0; n < 2; ++n) acc[a][b][m][n] = (f32x4){0.f, 0.f, 0.f, 0.f};
    bf16x8 At[4][2], B0[2][2], B1[2][2];
    const char* cA = (const char*)g.A + (size_t)cur.pm * tstep; const char* cB = (const char*)g.Bt + (size_t)cur.pn * tstep;
    S.a_ready(cur);
    if constexpr (SP2) {
        PG8_STAGE(PG8_SB(0, 0), cB, voffB); PG8_STAGE(PG8_SB(0, 1), cB + hstep, voffB); PG8_STAGE(PG8_SA(0, 0), cA, voffA); PG8_STAGE(PG8_SA(0, 1), cA + hstep, voffA);
        if (wr == 1) PG8_BAR;
        PG8_WAIT_V(2); PG8_BAR;
        PG8_STAGE(PG8_SB(1, 0), cB + kstep, voffB); PG8_STAGE(PG8_SA(1, 0), cA + kstep, voffA); PG8_STAGE(PG8_SB(1, 1), cB + hstep + kstep, voffB);
        PG8_WAIT_V(6); PG8_BAR;
    } else {
        PG8_STAGE(PG8_SB(0, 0), cB, voffB); PG8_STAGE(PG8_SA(0, 0), cA, voffA); PG8_STAGE(PG8_SB(0, 1), cB + hstep, voffB); PG8_STAGE(PG8_SA(0, 1), cA + hstep, voffA);
        if (wr == 1) PG8_BAR;
        PG8_WAIT_V(4); PG8_BAR;
        PG8_STAGE(PG8_SB(1, 0), cB + kstep, voffB); PG8_STAGE(PG8_SA(1, 0), cA + kstep, voffA); PG8_STAGE(PG8_SB(1, 1), cB + hstep + kstep, voffB);
        PG8_WAIT_V(6); PG8_BAR;
    }
    for (;;) {
        const bool has_next = S.next(ui + 1, nxt);
        const char* nA = has_next ? (const char*)g.A + (size_t)nxt.pm * tstep : cA; const char* nB = has_next ? (const char*)g.Bt + (size_t)nxt.pn * tstep : cB;
        for (int t = 0; t < nt; t += 2) {
            const bool last = (t == nt - 2);
            const char* a1 = cA + (size_t)(t + 1) * kstep;
            const char* a2 = last ? nA : cA + (size_t)(t + 2) * kstep; const char* b2 = last ? nB : cB + (size_t)(t + 2) * kstep;
            const char* a3 = a2 + kstep; const char* b3 = b2 + kstep;
            if (last && has_next) S.a_ready(nxt);
            if constexpr (SP2) {
            PG8_LDB(B0, 0, 0); PG8_LDB(B1, 0, 1); PG8_SCHED; PG8_LDA(At, 0, 0); PG8_STAGE(PG8_SA(1, 1), a1 + hstep, voffA);
            PG8_WAIT_V(8); PG8_WAIT_L(0); PG8_BAR; PG8_MMA(0, 0, At, B0); PG8_MMA(0, 1, At, B1); PG8_BAR; PG8_SCHED;
            PG8_LDA(At, 0, 1); PG8_STAGE(PG8_SB(0, 0), b2, voffB); PG8_STAGE(PG8_SB(0, 1), b2 + hstep, voffB); PG8_STAGE(PG8_SA(0, 0), a2, voffA);
            PG8_WAIT_V(8); PG8_WAIT_L(0); PG8_BAR; PG8_MMA(1, 0, At, B0); PG8_MMA(1, 1, At, B1); PG8_BAR; PG8_SCHED;
            PG8_LDB(B0, 1, 0); PG8_LDB(B1, 1, 1); PG8_SCHED; PG8_LDA(At, 1, 0); PG8_STAGE(PG8_SA(0, 1), a2 + hstep, voffA);
            PG8_WAIT_V(8); PG8_WAIT_L(0); PG8_BAR; PG8_MMA(0, 0, At, B0); PG8_MMA(0, 1, At, B1); PG8_BAR; PG8_SCHED;
            PG8_LDA(At, 1, 1); PG8_STAGE(PG8_SB(1, 0), b3, voffB); PG8_STAGE(PG8_SB(1, 1), b3 + hstep, voffB); PG8_STAGE(PG8_SA(1, 0), a3, voffA);
            PG8_WAIT_V(8); PG8_WAIT_L(0); PG8_BAR; PG8_MMA(1, 0, At, B0); PG8_MMA(1, 1, At, B1); PG8_BAR; PG8_SCHED;
            } else {
            PG8_LDB(B0, 0, 0); PG8_SCHED; PG8_LDA(At, 0, 0); PG8_STAGE(PG8_SA(1, 1), a1 + hstep, voffA);
            PG8_WAIT_L(8); PG8_BAR; PG8_WAIT_L(0); PG8_MMA(0, 0, At, B0); PG8_BAR; PG8_SCHED;
            PG8_LDB(B1, 0, 1); PG8_STAGE(PG8_SB(0, 0), b2, voffB);
            PG8_BAR; PG8_WAIT_L(0); PG8_MMA(0, 1, At, B1); PG8_BAR;
            PG8_LDA(At, 0, 1); PG8_STAGE(PG8_SA(0, 0), a2, voffA);
            PG8_BAR; PG8_WAIT_L(0); PG8_MMA(1, 0, At, B0); PG8_BAR; PG8_SCHED;
            PG8_STAGE(PG8_SB(0, 1), b2 + hstep, voffB);
            PG8_WAIT_V(6); PG8_BAR; PG8_MMA(1, 1, At, B1); PG8_BAR;
            PG8_LDB(B0, 1, 0); PG8_SCHED; PG8_LDA(At, 1, 0); PG8_STAGE(PG8_SA(0, 1), a2 + hstep, voffA);
            PG8_WAIT_L(8); PG8_BAR; PG8_WAIT_L(0); PG8_MMA(0, 0, At, B0); PG8_BAR; PG8_SCHED;
            PG8_LDB(B1, 1, 1); PG8_STAGE(PG8_SB(1, 0), b3, voffB);
            PG8_BAR; PG8_WAIT_L(0); PG8_MMA(0, 1, At, B1); PG8_BAR;
            PG8_LDA(At, 1, 1); PG8_STAGE(PG8_SA(1, 0), a3, voffA);
            PG8_BAR; PG8_WAIT_L(0); PG8_MMA(1, 0, At, B0); PG8_BAR; PG8_SCHED;
            PG8_STAGE(PG8_SB(1, 1), b3 + hstep, voffB);
            PG8_WAIT_V(6); PG8_BAR; PG8_MMA(1, 1, At, B1); PG8_BAR;
            }
        }
        if constexpr (ALIGN_EPI) { if (wr == 0) PG8_BAR; }
        if constexpr (!Epi::AFTER_DRAIN) { E(acc, cur, wr, wc, fr, fq); S.done(cur); }
        if (!has_next) break;
#pragma unroll
        for (int a = 0; a < 2; ++a)
#pragma unroll
            for (int b = 0; b < 2; ++b)
#pragma unroll
                for (int m = 0; m < 4; ++m)
#pragma unroll
                    for (int n = 0; n < 2; ++n) acc[a][b][m][n] = (f32x4){0.f, 0.f, 0.f, 0.f};
        cur = nxt; cA = nA; cB = nB; ++ui;
        if constexpr (ALIGN_EPI) { if (wr == 1) PG8_BAR; }
    }
    PG8_WAIT_V(0);
    if constexpr (!ALIGN_EPI) { if (wr == 0) PG8_BAR; }
    PG8_BAR;
    if constexpr (Epi::AFTER_DRAIN) { E.fused(acc, cur, wr, wc, fr, fq, lds, wid, lane); S.done(cur); }
#undef PG8_SA
#undef PG8_SB
#undef PG8_STAGE
#undef PG8_LDA
#undef PG8_LDB
#undef PG8_MMA
#undef PG8_WAIT_V
#undef PG8_WAIT_L
#undef PG8_BAR
#undef PG8_SCHED
}
}
constexpr int BATCH = 2, SEQ = 8192, DM = 2048, NTOK = BATCH * SEQ, DIN = 6144, MEML = 256;
constexpr int NH = 8, HD = 128, NHM = 4, NBLK = 32, BLK = 256;
constexpr int ZQ = 0, ZK = 1024, ZV = 2048, ZGA = 3072, ZU = 4096, ZGP = 4608, ZQM = 5120, ZGM = 5632;
constexpr float EPS = 1e-6f;
constexpr float SM_C = 0.08838834764831845f * 1.4426950408889634f;

constexpr size_t MiB = 1u << 20;
constexpr size_t WS_CNT = 0;
constexpr size_t WS_KMH = 1 * MiB, WS_KML = WS_KMH + 131072, WS_WPT = WS_KML + 131072;
constexpr size_t WS_MK = 2 * MiB;
constexpr size_t WS_MVT = 3 * MiB;
constexpr size_t WS_MEMH = 4 * MiB;
constexpr size_t WS_WMEMT = 6 * MiB;
constexpr size_t WS_WOUTT = 10 * MiB;
constexpr size_t WS_WINT = 18 * MiB;
constexpr size_t WS_LIST = 42 * MiB;
constexpr size_t WS_ML = 58 * MiB;
constexpr size_t WS_H = 64 * MiB;
constexpr size_t WS_Y = WS_H;
constexpr size_t WS_Z = 128 * MiB;
constexpr size_t WS_VT = 320 * MiB;
constexpr size_t WS_OP = 352 * MiB;
constexpr size_t WS_END = 448 * MiB;

constexpr int LDS_BYTES = 147456;
constexpr int KL_OFF = 0, KL_STRIDE = 272, VL_OFF = 256 * KL_STRIDE, VL_STRIDE = 528, PRE_OFF = VL_OFF + 128 * VL_STRIDE;
static_assert(PRE_OFF + 520 * 4 + 64 <= LDS_BYTES, "lds map");

#define LAS __attribute__((address_space(3)))
typedef unsigned short bf16;
typedef short bf16x8 __attribute__((ext_vector_type(8)));
typedef float f32x4 __attribute__((ext_vector_type(4)));
typedef float f32x16 __attribute__((ext_vector_type(16)));
typedef unsigned u32x4 __attribute__((ext_vector_type(4)));
typedef unsigned u32x2 __attribute__((ext_vector_type(2)));
typedef float f32x2_t __attribute__((ext_vector_type(2)));
typedef __bf16 bf16x2_t __attribute__((ext_vector_type(2)));
#define DI __device__ __forceinline__
DI unsigned cvtpk(float lo, float hi) { f32x2_t v = {lo, hi}; bf16x2_t b = __builtin_convertvector(v, bf16x2_t); return __builtin_bit_cast(unsigned, b); }
DI float bflo(unsigned u) { return __uint_as_float(u << 16); }
DI float bfhi(unsigned u) { return __uint_as_float(u & 0xffff0000u); }
DI float wave_sum(float v) {
#pragma unroll
    for (int o = 1; o < 64; o <<= 1) v += __shfl_xor(v, o);
    return v;
}
DI int crow(int i, int h) { return (i & 3) + 8 * (i >> 2) + 4 * h; }
DI int pi32(int r) { return (r & ~12) | ((r & 4) << 1) | ((r & 8) >> 1); }
DI float silu(float g) { return g / (1.0f + __expf(-g)); }
#define MFMA32(a, b, c) __builtin_amdgcn_mfma_f32_32x32x16_bf16((a), (b), (c), 0, 0, 0)

struct Params {
    const float *x, *mem, *norm_g, *mem_norm_g, *w_in, *w_mem_kv, *w_pool, *pool_scale, *w_out, *final_g;
    float* out; unsigned char* ws;
};

struct EpiResF32 {
    static constexpr bool PERM = false, AFTER_DRAIN = false;
    const float* base; float* out; int ldc;
    __device__ __forceinline__ void operator()(const pg8::f32x4 (&acc)[2][2][4][2], const pg8::Unit& u, int wr, int wc, int fr, int fq) const {
        const int col0 = u.pn * pg8::BM + wc * 32 + 4 * fq;
#pragma unroll
        for (int ai = 0; ai < 2; ++ai)
#pragma unroll
            for (int m = 0; m < 4; ++m) {
                const size_t off = (size_t)(u.pm * pg8::BM + ai * pg8::HALF + wr * 64 + m * 16 + fr) * ldc + col0;
#pragma unroll
                for (int bj = 0; bj < 2; ++bj)
#pragma unroll
                    for (int n = 0; n < 2; ++n) {
                        const pg8::f32x4 b = *(const pg8::f32x4*)(base + off + bj * pg8::HALF + n * 16);
                        *(pg8::f32x4*)(out + off + bj * pg8::HALF + n * 16) = acc[ai][bj][m][n] + b;
                    }
            }
    }
};
struct EpiZ {
    static constexpr bool PERM = true, AFTER_DRAIN = false;
    bf16* O; int ldc;
    __device__ __forceinline__ void operator()(const pg8::f32x4 (&acc)[2][2][4][2], const pg8::Unit& u, int wr, int wc, int fr, int fq) const {
        const int row0 = u.pm * pg8::BM + wr * 64 + fr; const int col0 = u.pn * pg8::BM + wc * 32 + 8 * fq;
#pragma unroll
        for (int ai = 0; ai < 2; ++ai)
#pragma unroll
            for (int m = 0; m < 4; ++m) { bf16* rowp = O + (size_t)(row0 + ai * pg8::HALF + m * 16) * ldc + col0;
#pragma unroll
                for (int bj = 0; bj < 2; ++bj) { const pg8::f32x4 v0 = acc[ai][bj][m][0], v1 = acc[ai][bj][m][1];
                    u32x4 w; w.x = cvtpk(v0[0], v0[1]); w.y = cvtpk(v0[2], v0[3]); w.z = cvtpk(v1[0], v1[1]); w.w = cvtpk(v1[2], v1[3]);
                    *(u32x4*)(rowp + bj * pg8::HALF) = w; } }
    }
};

DI void transpose_item(const float* W, int K, int N, bf16* WT, LAS float* scr, int item, int lane) {
    const int nblk = N / 32, kb = item / nblk, nb = item % nblk, k0 = 64 * kb, n0 = 32 * nb;
#pragma unroll 8
    for (int i = 0; i < 32; ++i) { const int kk = 2 * i + (lane >> 5); scr[kk * 33 + (lane & 31)] = W[(size_t)(k0 + kk) * N + n0 + (lane & 31)]; }
    __builtin_amdgcn_fence(__ATOMIC_RELEASE, "wavefront"); asm volatile("s_waitcnt lgkmcnt(0)" ::: "memory");
    const int c = lane & 7;
#pragma unroll
    for (int j = 0; j < 4; ++j) { const int n = (lane >> 3) + 8 * j; const LAS float* s = scr + (8 * c) * 33 + n;
        u32x4 o; o.x = cvtpk(s[0 * 33], s[1 * 33]); o.y = cvtpk(s[2 * 33], s[3 * 33]); o.z = cvtpk(s[4 * 33], s[5 * 33]); o.w = cvtpk(s[6 * 33], s[7 * 33]);
        *(u32x4*)(WT + (size_t)(n0 + n) * K + k0 + 8 * c) = o; }
    asm volatile("s_waitcnt lgkmcnt(0)" ::: "memory");
}
DI void rms_row_bf16(const float* xrow, const float* g, bf16* orow, int lane) {
    const f32x4* xr = (const f32x4*)xrow + lane; const f32x4* gr = (const f32x4*)g + lane;
    f32x4 v[8]; float s = 0.f;
#pragma unroll
    for (int j = 0; j < 8; ++j) { v[j] = xr[64 * j]; s += (v[j].x * v[j].x + v[j].y * v[j].y) + (v[j].z * v[j].z + v[j].w * v[j].w); }
    const float rstd = 1.0f / sqrtf(wave_sum(s) * (1.f / DM) + EPS);
    u32x2* o8 = (u32x2*)orow + lane;
#pragma unroll
    for (int j = 0; j < 8; ++j) { const f32x4 gg = gr[64 * j]; u32x2 w; w.x = cvtpk(v[j].x * rstd * gg.x, v[j].y * rstd * gg.y); w.y = cvtpk(v[j].z * rstd * gg.z, v[j].w * rstd * gg.w); o8[64 * j] = w; }
}
DI void rms_row_f32(float* row, const float* g, int lane) {
    f32x4* xr = (f32x4*)row + lane; const f32x4* gr = (const f32x4*)g + lane;
    f32x4 v[8]; float s = 0.f;
#pragma unroll
    for (int j = 0; j < 8; ++j) { v[j] = xr[64 * j]; s += (v[j].x * v[j].x + v[j].y * v[j].y) + (v[j].z * v[j].z + v[j].w * v[j].w); }
    const float rstd = 1.0f / sqrtf(wave_sum(s) * (1.f / DM) + EPS);
#pragma unroll
    for (int j = 0; j < 8; ++j) { const f32x4 gg = gr[64 * j]; xr[64 * j] = v[j] * rstd * gg; }
}

DI void attn_core(const LAS unsigned char* lds, const bf16x8 (&qf)[8], int ntiles, bool causal, int qlocal, int r, int hh, f32x16 (&o)[4], float& m, float& l) {
    m = -1e30f; l = 0.f;
#pragma unroll
    for (int dt = 0; dt < 4; ++dt)
#pragma unroll
        for (int i = 0; i < 16; ++i) o[dt][i] = 0.f;
    const LAS unsigned char* kbase = lds + KL_OFF + pi32(r) * KL_STRIDE + 16 * hh;
    const LAS unsigned char* vbase = lds + VL_OFF + r * VL_STRIDE + 16 * hh;
    for (int kt = 0; kt < ntiles; ++kt) {
        f32x16 s;
#pragma unroll
        for (int i = 0; i < 16; ++i) s[i] = 0.f;
        const LAS unsigned char* kp = kbase + kt * 32 * KL_STRIDE;
#pragma unroll
        for (int d0 = 0; d0 < 8; ++d0) { const bf16x8 kf = *(const LAS bf16x8*)(kp + 32 * d0); s = MFMA32(kf, qf[d0], s); }
        if (causal) {
#pragma unroll
            for (int i = 0; i < 16; ++i) { const int kl = 32 * kt + 16 * (i >> 3) + 8 * hh + (i & 7); if (kl > qlocal) s[i] = -INFINITY; }
        }
        float mx = s[0];
#pragma unroll
        for (int i = 1; i < 16; ++i) mx = fmaxf(mx, s[i]);
        mx = fmaxf(mx, __shfl_xor(mx, 32));
        const float mn = fmaxf(m, mx);
        const float alpha = __builtin_amdgcn_exp2f((m - mn) * SM_C);
        const float mnc = mn * SM_C;
        float ps = 0.f;
#pragma unroll
        for (int i = 0; i < 16; ++i) { s[i] = __builtin_amdgcn_exp2f(s[i] * SM_C - mnc); ps += s[i]; }
        l = l * alpha + ps; m = mn;
#pragma unroll
        for (int dt = 0; dt < 4; ++dt)
#pragma unroll
            for (int i = 0; i < 16; ++i) o[dt][i] *= alpha;
        u32x4 p0, p1;
        p0.x = cvtpk(s[0], s[1]); p0.y = cvtpk(s[2], s[3]); p0.z = cvtpk(s[4], s[5]); p0.w = cvtpk(s[6], s[7]);
        p1.x = cvtpk(s[8], s[9]); p1.y = cvtpk(s[10], s[11]); p1.z = cvtpk(s[12], s[13]); p1.w = cvtpk(s[14], s[15]);
        const bf16x8 pb0 = __builtin_bit_cast(bf16x8, p0), pb1 = __builtin_bit_cast(bf16x8, p1);
        const LAS unsigned char* vp = vbase + kt * 64;
#pragma unroll
        for (int dt = 0; dt < 4; ++dt) {
            const bf16x8 v0 = *(const LAS bf16x8*)(vp + dt * 32 * VL_STRIDE);
            const bf16x8 v1 = *(const LAS bf16x8*)(vp + dt * 32 * VL_STRIDE + 32);
            o[dt] = MFMA32(v0, pb0, o[dt]);
            o[dt] = MFMA32(v1, pb1, o[dt]);
        }
    }
}
DI void load_kv(LAS unsigned char* lds, const bf16* Kg, size_t kstride, const bf16* Vg, size_t vstride, int tid) {
#pragma unroll
    for (int it = 0; it < 8; ++it) { const int id = tid + 512 * it, row = id >> 4, ch = id & 15;
        const u32x4 v = *(const u32x4*)(Kg + (size_t)row * kstride + ch * 8); *(LAS u32x4*)(lds + KL_OFF + row * KL_STRIDE + ch * 16) = v; }
#pragma unroll
    for (int it = 0; it < 8; ++it) { const int id = tid + 512 * it, d = id >> 5, ch = id & 31;
        const u32x4 v = *(const u32x4*)(Vg + (size_t)d * vstride + ch * 8); *(LAS u32x4*)(lds + VL_OFF + d * VL_STRIDE + ch * 16) = v; }
}
DI void load_q(bf16x8 (&qf)[8], const bf16* qrow, int hh) {
#pragma unroll
    for (int d0 = 0; d0 < 8; ++d0) qf[d0] = *(const bf16x8*)(qrow + 16 * d0 + 8 * hh);
}

__global__ void __launch_bounds__(512, 2) hybrid_fwd(Params p) {
    extern __shared__ __attribute__((aligned(16))) unsigned char lds_raw[];
    LAS unsigned char* lds = (LAS unsigned char*)lds_raw;
    cg::grid_group grid = cg::this_grid();
    const int tid = threadIdx.x, lane = tid & 63, wave = __builtin_amdgcn_readfirstlane(tid >> 6);
    const int G = gridDim.x, bx = blockIdx.x;
    const int gw = bx * 8 + wave, NGW = G * 8;
    const int r = lane & 31, hh = lane >> 5;
    unsigned char* ws = p.ws;
    unsigned* gcount = (unsigned*)(ws + WS_CNT);
    bf16* KMH = (bf16*)(ws + WS_KMH); bf16* KML = (bf16*)(ws + WS_KML); bf16* WPT = (bf16*)(ws + WS_WPT);
    bf16* MK = (bf16*)(ws + WS_MK); bf16* MVT = (bf16*)(ws + WS_MVT); bf16* MEMH = (bf16*)(ws + WS_MEMH);
    bf16* WMEMT = (bf16*)(ws + WS_WMEMT); bf16* WOUTT = (bf16*)(ws + WS_WOUTT); bf16* WINT = (bf16*)(ws + WS_WINT);
    unsigned* LIST = (unsigned*)(ws + WS_LIST); f32x2_t* MLB = (f32x2_t*)(ws + WS_ML);
    bf16* H = (bf16*)(ws + WS_H); bf16* Y = (bf16*)(ws + WS_Y); bf16* Z = (bf16*)(ws + WS_Z); bf16* VT = (bf16*)(ws + WS_VT); bf16* OP = (bf16*)(ws + WS_OP);

    {
        LAS float* scr = (LAS float*)(lds + wave * 16384);
        constexpr int I_IN = (DM / 64) * (DIN / 32), I_OUT = (DM / 64) * (DM / 32), I_MEM = (DM / 64) * (1024 / 32), I_POOL = 4 * 2 * 4;
        constexpr int NIT = I_IN + I_OUT + I_MEM + I_POOL;
        for (int it = gw; it < NIT; it += NGW) {
            int q = it;
            if (q < I_IN) { transpose_item(p.w_in, DM, DIN, WINT, scr, q, lane); continue; } q -= I_IN;
            if (q < I_OUT) { transpose_item(p.w_out, DM, DM, WOUTT, scr, q, lane); continue; } q -= I_OUT;
            if (q < I_MEM) { transpose_item(p.w_mem_kv, DM, 1024, WMEMT, scr, q, lane); continue; } q -= I_MEM;
            { const int g = q >> 3; transpose_item(p.w_pool + g * 16384, 128, 128, WPT + g * 16384, scr, q & 7, lane); }
        }
        for (int m = gw; m < NTOK + BATCH * MEML; m += NGW) {
            if (m < NTOK) rms_row_bf16(p.x + (size_t)m * DM, p.norm_g, H + (size_t)m * DM, lane);
            else { const int mm = m - NTOK; rms_row_bf16(p.mem + (size_t)mm * DM, p.mem_norm_g, MEMH + (size_t)mm * DM, lane); }
        }
        if (bx == 0) gcount[tid] = 0u;
    }
    grid.sync();

    {
        pg8::Gemm g{H, WINT, NTOK, DIN, DM}; pg8::StaticOrder S; S.init(NTOK, DIN, G, bx);
        EpiZ E{Z, DIN};
        pg8::gemm_phase<EpiZ, pg8::StaticOrder, true, true>(lds, g, S, E);
    }
    grid.sync();

    {
        for (int tt = gw; tt < 32 * 64; tt += NGW) {
            const int tr = tt >> 6, tc = tt & 63, row = lane & 15, quad = lane >> 4;
            const bf16* ap = MEMH + (size_t)(16 * tr + row) * DM + quad * 8;
            const bf16* bp = WMEMT + (size_t)(16 * tc + row) * DM + quad * 8;
            f32x4 acc = {0.f, 0.f, 0.f, 0.f};
#pragma unroll 8
            for (int k0 = 0; k0 < DM; k0 += 32) {
                const bf16x8 a = *(const bf16x8*)(ap + k0), b = *(const bf16x8*)(bp + k0);
                acc = __builtin_amdgcn_mfma_f32_16x16x32_bf16(a, b, acc, 0, 0, 0);
            }
            const int gc = 16 * tc + row, gr0 = 16 * tr + quad * 4;
            if (gc < 512) {
#pragma unroll
                for (int j = 0; j < 4; ++j) MK[(size_t)(gr0 + j) * 512 + gc] = (bf16)(cvtpk(acc[j], 0.f) & 0xffffu);
            } else {
                const int dc = gc - 512, hm = dc >> 7, d = dc & 127, b = gr0 >> 8, m0 = gr0 & 255;
                u32x2 w; w.x = cvtpk(acc[0], acc[1]); w.y = cvtpk(acc[2], acc[3]);
                *(u32x2*)(MVT + ((size_t)((b * NHM + hm) * 128 + d)) * 256 + m0) = w;
            }
        }
        LAS unsigned* vt32 = (LAS unsigned*)lds;
        LAS bf16* vt16 = (LAS bf16*)lds;
        LAS float* ksum = (LAS float*)(lds + 256 * 65 * 4);
        for (int item = bx; item < BATCH * NH * NBLK; item += G) {
            const int j = item & 31, h = (item >> 5) & 7, b = item >> 8;
            const size_t tok0 = (size_t)b * SEQ + (size_t)j * BLK;
            {
                const int c2 = tid & 63, w = tid >> 6;
                float a0 = 0.f, a1 = 0.f;
                const bf16* kp = Z + (tok0 + 32 * w) * DIN + ZK + h * HD + 2 * c2;
#pragma unroll 8
                for (int rr = 0; rr < 32; ++rr) { const unsigned u = *(const unsigned*)(kp + (size_t)rr * DIN); a0 += bflo(u); a1 += bfhi(u); }
                ksum[w * 128 + 2 * c2] = a0; ksum[w * 128 + 2 * c2 + 1] = a1;
            }
#pragma unroll
            for (int it = 0; it < 8; ++it) { const int id = tid + 512 * it, row = id >> 4, ch = id & 15;
                const u32x4 v = *(const u32x4*)(Z + (tok0 + row) * DIN + ZV + h * HD + ch * 8);
                LAS unsigned* d = vt32 + row * 65 + ch * 4; d[0] = v.x; d[1] = v.y; d[2] = v.z; d[3] = v.w; }
            __syncthreads();
            if (tid < 128) {
                float s = 0.f;
#pragma unroll
                for (int w = 0; w < 8; ++w) s += ksum[w * 128 + tid];
                s *= (1.0f / 256.0f);
                const unsigned hi = cvtpk(s, 0.f) & 0xffffu; const float lo = s - __uint_as_float(hi << 16);
                KMH[(size_t)item * 128 + tid] = (bf16)hi; KML[(size_t)item * 128 + tid] = (bf16)(cvtpk(lo, 0.f) & 0xffffu);
            }
#pragma unroll
            for (int it = 0; it < 8; ++it) { const int d = (tid >> 5) + 16 * it, kc = tid & 31;
                unsigned e[8];
#pragma unroll
                for (int jj = 0; jj < 8; ++jj) e[jj] = vt16[(8 * kc + jj) * 130 + d];
                u32x4 o; o.x = e[0] | (e[1] << 16); o.y = e[2] | (e[3] << 16); o.z = e[4] | (e[5] << 16); o.w = e[6] | (e[7] << 16);
                *(u32x4*)(VT + ((size_t)((b * NH + h) * 128 + d)) * SEQ + j * BLK + 8 * kc) = o; }
            __syncthreads();
        }
    }
    grid.sync();

    {
        LAS float* gl = (LAS float*)lds;
        LAS unsigned* lcnt = (LAS unsigned*)(lds + 8 * 32 * 33 * 4);
        LAS unsigned* lbase = lcnt + 32;
        for (int item = bx; item < BATCH * NH * NBLK; item += G) {
            const int i = item & 31, h = (item >> 5) & 7, b = item >> 8, bh = item >> 5;
            if (i == 0) continue;
            const int s_q = i * BLK + wave * 32 + r;
            bf16x8 qf[8]; load_q(qf, Z + ((size_t)b * SEQ + s_q) * DIN + ZQ + h * HD, hh);
            f32x16 acc;
#pragma unroll
            for (int ii = 0; ii < 16; ++ii) acc[ii] = 0.f;
            const bf16* kmh = KMH + ((size_t)(bh * 32 + r)) * 128 + 8 * hh; const bf16* kml = KML + ((size_t)(bh * 32 + r)) * 128 + 8 * hh;
#pragma unroll
            for (int d0 = 0; d0 < 8; ++d0) { const bf16x8 a = *(const bf16x8*)(kmh + 16 * d0); acc = MFMA32(a, qf[d0], acc); }
#pragma unroll
            for (int d0 = 0; d0 < 8; ++d0) { const bf16x8 a = *(const bf16x8*)(kml + 16 * d0); acc = MFMA32(a, qf[d0], acc); }
#pragma unroll
            for (int ii = 0; ii < 16; ++ii) gl[(wave * 32 + r) * 33 + crow(ii, hh)] = acc[ii];
            if (tid < 32) lcnt[tid] = 0u;
            __syncthreads();
            int i0 = -1, i1 = -1, i2 = -1; unsigned r0 = 0, r1 = 0, r2 = 0;
            if (hh == 0) {
                float v0 = -INFINITY, v1 = -INFINITY, v2 = -INFINITY;
                const LAS float* gp = gl + (wave * 32 + r) * 33;
                for (int n = 0; n < i; ++n) {
                    const float v = gp[n];
                    if (v > v0) { v2 = v1; i2 = i1; v1 = v0; i1 = i0; v0 = v; i0 = n; }
                    else if (v > v1) { v2 = v1; i2 = i1; v1 = v; i1 = n; }
                    else if (v > v2) { v2 = v; i2 = n; }
                }
                if (i0 >= 0) r0 = atomicAdd((unsigned*)(lcnt + i0), 1u);
                if (i1 >= 0) r1 = atomicAdd((unsigned*)(lcnt + i1), 1u);
                if (i2 >= 0) r2 = atomicAdd((unsigned*)(lcnt + i2), 1u);
            }
            __syncthreads();
            if (tid < i) lbase[tid] = atomicAdd(gcount + bh * 32 + tid, lcnt[tid]);
            __syncthreads();
            if (hh == 0) {
                if (i0 >= 0) LIST[(size_t)(bh * 32 + i0) * 8192 + lbase[i0] + r0] = (unsigned)s_q;
                if (i1 >= 0) LIST[(size_t)(bh * 32 + i1) * 8192 + lbase[i1] + r1] = (unsigned)s_q | (1u << 16);
                if (i2 >= 0) LIST[(size_t)(bh * 32 + i2) * 8192 + lbase[i2] + r2] = (unsigned)s_q | (2u << 16);
            }
            __syncthreads();
        }
        for (int it = gw; it < (NTOK / 32) * 4; it += NGW) {
            const int g = it & 3, tt = it >> 2, T0 = tt * 32, win = 2 << g;
            const int tok = T0 + r, tpos = tok & (SEQ - 1);
            const int cnt = (tpos + 1 < win) ? tpos + 1 : win;
            const float fc = (float)cnt;
            f32x16 acc[4];
#pragma unroll
            for (int dt = 0; dt < 4; ++dt)
#pragma unroll
                for (int ii = 0; ii < 16; ++ii) acc[dt][ii] = 0.f;
            const bf16* up = Z + (size_t)tok * DIN + ZU + g * 128 + 8 * hh;
            const bf16* wp = WPT + (size_t)g * 16384 + (size_t)r * 128 + 8 * hh;
            for (int kk = 0; kk < 8; ++kk) {
                float sm[8];
                const u32x4 u0 = *(const u32x4*)(up + 16 * kk);
                sm[0] = bflo(u0.x); sm[1] = bfhi(u0.x); sm[2] = bflo(u0.y); sm[3] = bfhi(u0.y); sm[4] = bflo(u0.z); sm[5] = bfhi(u0.z); sm[6] = bflo(u0.w); sm[7] = bfhi(u0.w);
                float own[8];
#pragma unroll
                for (int e = 0; e < 8; ++e) own[e] = sm[e];
                for (int w = 1; w < win; ++w) {
                    if (w < cnt) {
                        const u32x4 u = *(const u32x4*)(up + 16 * kk - (size_t)w * DIN);
                        sm[0] += bflo(u.x); sm[1] += bfhi(u.x); sm[2] += bflo(u.y); sm[3] += bfhi(u.y); sm[4] += bflo(u.z); sm[5] += bfhi(u.z); sm[6] += bflo(u.w); sm[7] += bfhi(u.w);
                    }
                }
                u32x4 pa;
                pa.x = cvtpk(sm[0] / fc - own[0], sm[1] / fc - own[1]); pa.y = cvtpk(sm[2] / fc - own[2], sm[3] / fc - own[3]);
                pa.z = cvtpk(sm[4] / fc - own[4], sm[5] / fc - own[5]); pa.w = cvtpk(sm[6] / fc - own[6], sm[7] / fc - own[7]);
                const bf16x8 a = __builtin_bit_cast(bf16x8, pa);
#pragma unroll
                for (int dt = 0; dt < 4; ++dt) { const bf16x8 bb = *(const bf16x8*)(wp + (size_t)dt * 32 * 128 + 16 * kk); acc[dt] = MFMA32(a, bb, acc[dt]); }
            }
#pragma unroll
            for (int dt = 0; dt < 4; ++dt) {
                const int col = g * 128 + 32 * dt + r; const float ps = p.pool_scale[col];
#pragma unroll
                for (int ii = 0; ii < 16; ++ii) {
                    const size_t t2 = (size_t)(T0 + crow(ii, hh));
                    const float gp = bflo((unsigned)Z[t2 * DIN + ZGP + col]);
                    Y[t2 * DM + 1024 + col] = (bf16)(cvtpk(acc[dt][ii] * ps * silu(gp), 0.f) & 0xffffu);
                }
            }
        }
    }
    grid.sync();

    for (int ph = 4; ph <= 5; ++ph) {
        LAS unsigned* pre = (LAS unsigned*)(lds + PRE_OFF);
        int it0, it1;
        if (ph == 4) {
            const unsigned nch = (gcount[tid] + 255u) >> 8;
            unsigned v = nch;
#pragma unroll
            for (int off = 1; off < 64; off <<= 1) { const unsigned n = __shfl_up(v, off); if (lane >= off) v += n; }
            if (lane == 63) pre[516 + wave] = v;
            __syncthreads();
            unsigned wb = 0;
            for (int w = 0; w < wave; ++w) wb += pre[516 + w];
            pre[tid + 1] = wb + v; if (tid == 0) pre[0] = 0u;
            __syncthreads();
            const unsigned T = pre[512];
            it0 = (int)(((unsigned long long)T * (unsigned)bx) / (unsigned)G); it1 = (int)(((unsigned long long)T * (unsigned)(bx + 1)) / (unsigned)G);
        } else { it0 = 0; it1 = 0; for (int x = bx; x < 768; x += G) ++it1; }
        int cur = -1;
        for (int itn = it0; itn < it1; ++itn) {
            int kind, b, h, jblk = 0, chunk = 0, qt = 0; unsigned cnt = 0; int lid = 0;
            if (ph == 4) {
                int lo = 0, hi2 = 512;
                while (hi2 - lo > 1) { const int mid = (lo + hi2) >> 1; if (pre[mid] <= (unsigned)itn) lo = mid; else hi2 = mid; }
                lid = lo; chunk = itn - (int)pre[lid]; kind = 0; jblk = lid & 31; h = (lid >> 5) & 7; b = lid >> 8; cnt = gcount[lid];
            } else {
                const int idx = bx + (itn - it0) * G;
                if (idx < 512) { kind = 1; jblk = idx & 31; h = (idx >> 5) & 7; b = idx >> 8; lid = idx; }
                else { const int mi = idx - 512; kind = 2; b = mi >> 7; h = (mi >> 5) & 3; qt = mi & 31; lid = 1024 + (mi >> 5); }
            }
            const int key = (ph == 4) ? lid : (kind == 1 ? lid : lid);
            if (ph == 5 || key != cur) {
                __syncthreads();
                if (kind == 2) load_kv(lds, MK + (size_t)(b * MEML) * 512 + h * HD, 512, MVT + (size_t)((b * NHM + h) * 128) * 256, 256, tid);
                else load_kv(lds, Z + ((size_t)b * SEQ + (size_t)jblk * BLK) * DIN + ZK + h * HD, DIN, VT + (size_t)((b * NH + h) * 128) * SEQ + jblk * BLK, SEQ, tid);
                __syncthreads();
                cur = key;
            }
            bool active = true, valid = true; int s_q, slot = 0;
            if (kind == 0) {
                const unsigned base = (unsigned)chunk * 256u + (unsigned)wave * 32u;
                active = base < cnt;
                unsigned e_i = base + (unsigned)r; valid = e_i < cnt; if (!valid) e_i = cnt - 1u;
                const unsigned e = active ? LIST[(size_t)lid * 8192 + e_i] : 0u;
                s_q = (int)(e & 0xffffu); slot = (int)(e >> 16);
            } else if (kind == 1) s_q = jblk * BLK + wave * 32 + r;
            else s_q = qt * BLK + wave * 32 + r;
            if (!active) continue;
            const size_t tok = (size_t)b * SEQ + s_q;
            bf16x8 qf[8]; load_q(qf, Z + tok * DIN + (kind == 2 ? ZQM : ZQ) + h * HD, hh);
            f32x16 o[4]; float m, l;
            attn_core(lds, qf, kind == 1 ? wave + 1 : 8, kind == 1, wave * 32 + r, r, hh, o, m, l);
            l += __shfl_xor(l, 32);
            const float m2 = m * SM_C;
            if (kind == 0) {
                if (valid) {
                    const float inv = 1.0f / l;
                    bf16* op = OP + (((size_t)slot * NTOK + tok) * NH + h) * HD + 4 * hh;
#pragma unroll
                    for (int dt = 0; dt < 4; ++dt)
#pragma unroll
                        for (int g4 = 0; g4 < 4; ++g4) { u32x2 w; w.x = cvtpk(o[dt][4 * g4] * inv, o[dt][4 * g4 + 1] * inv); w.y = cvtpk(o[dt][4 * g4 + 2] * inv, o[dt][4 * g4 + 3] * inv);
                            *(u32x2*)(op + 32 * dt + 8 * g4) = w; }
                    if (hh == 0) { f32x2_t ml = {m2, l}; MLB[((size_t)slot * NTOK + tok) * NH + h] = ml; }
                }
            } else if (kind == 1) {
                const int nv = jblk < 3 ? jblk : 3;
                float mk[3], lk[3]; float M = m2;
#pragma unroll
                for (int k = 0; k < 3; ++k) { mk[k] = -1e30f; lk[k] = 0.f; if (k < nv) { const f32x2_t ml = MLB[((size_t)k * NTOK + tok) * NH + h]; mk[k] = ml.x; lk[k] = ml.y; M = fmaxf(M, ml.x); } }
                const float w0 = __builtin_amdgcn_exp2f(m2 - M); float L = l * w0; float wk[3];
#pragma unroll
                for (int k = 0; k < 3; ++k) { wk[k] = (k < nv) ? lk[k] * __builtin_amdgcn_exp2f(mk[k] - M) : 0.f; L += wk[k]; }
                const float inv = 1.0f / L;
                const bf16* gp = Z + tok * DIN + ZGA + h * HD + 4 * hh;
                bf16* yp = Y + tok * DM + h * HD + 4 * hh;
#pragma unroll
                for (int dt = 0; dt < 4; ++dt)
#pragma unroll
                    for (int g4 = 0; g4 < 4; ++g4) {
                        float a0 = o[dt][4 * g4] * w0, a1 = o[dt][4 * g4 + 1] * w0, a2 = o[dt][4 * g4 + 2] * w0, a3 = o[dt][4 * g4 + 3] * w0;
#pragma unroll
                        for (int k = 0; k < 3; ++k) if (k < nv) {
                            const u32x2 pv = *(const u32x2*)(OP + (((size_t)k * NTOK + tok) * NH + h) * HD + 4 * hh + 32 * dt + 8 * g4);
                            a0 += wk[k] * bflo(pv.x); a1 += wk[k] * bfhi(pv.x); a2 += wk[k] * bflo(pv.y); a3 += wk[k] * bfhi(pv.y);
                        }
                        const u32x2 gv = *(const u32x2*)(gp + 32 * dt + 8 * g4);
                        u32x2 w; w.x = cvtpk(a0 * inv * silu(bflo(gv.x)), a1 * inv * silu(bfhi(gv.x))); w.y = cvtpk(a2 * inv * silu(bflo(gv.y)), a3 * inv * silu(bfhi(gv.y)));
                        *(u32x2*)(yp + 32 * dt + 8 * g4) = w;
                    }
            } else {
                const float inv = 1.0f / l;
                const bf16* gp = Z + tok * DIN + ZGM + h * HD + 4 * hh;
                bf16* yp = Y + tok * DM + 1536 + h * HD + 4 * hh;
#pragma unroll
                for (int dt = 0; dt < 4; ++dt)
#pragma unroll
                    for (int g4 = 0; g4 < 4; ++g4) {
                        const u32x2 gv = *(const u32x2*)(gp + 32 * dt + 8 * g4);
                        u32x2 w; w.x = cvtpk(o[dt][4 * g4] * inv * silu(bflo(gv.x)), o[dt][4 * g4 + 1] * inv * silu(bfhi(gv.x)));
                        w.y = cvtpk(o[dt][4 * g4 + 2] * inv * silu(bflo(gv.y)), o[dt][4 * g4 + 3] * inv * silu(bfhi(gv.y)));
                        *(u32x2*)(yp + 32 * dt + 8 * g4) = w;
                    }
            }
        }
        __syncthreads();
        grid.sync();
    }

    {
        pg8::Gemm g{Y, WOUTT, NTOK, DM, DM}; pg8::StaticOrder S; S.init(NTOK, DM, G, bx);
        EpiResF32 E{p.x, p.out, DM};
        pg8::gemm_phase<EpiResF32, pg8::StaticOrder, true, true>(lds, g, S, E);
    }
    grid.sync();

    for (int m = gw; m < NTOK; m += NGW) rms_row_f32(p.out + (size_t)m * DM, p.final_g, lane);
}

extern "C" void kernel_launch(void* const* d_in, const int* in_sizes, int n_in, void* d_out, int out_size, void* d_ws, size_t ws_size, hipStream_t stream) {
    static int grid = 0;
    if (grid == 0) {
        if (n_in != 10 || in_sizes[0] != NTOK * DM || out_size != NTOK * DM || ws_size < WS_END) {
            fprintf(stderr, "kernel_launch: unexpected shapes (n_in %d, in0 %d, out %d, ws %zu)\n", n_in, n_in > 0 ? in_sizes[0] : -1, out_size, ws_size); grid = -1; return; }
        int dev = 0, cus = 0, per_cu = 0;
        hipGetDevice(&dev); hipDeviceGetAttribute(&cus, hipDeviceAttributeMultiprocessorCount, dev);
        if (hipFuncSetAttribute((const void*)hybrid_fwd, hipFuncAttributeMaxDynamicSharedMemorySize, LDS_BYTES) != hipSuccess) { fprintf(stderr, "kernel_launch: hipFuncSetAttribute failed\n"); grid = -1; return; }
        if (hipOccupancyMaxActiveBlocksPerMultiprocessor(&per_cu, (const void*)hybrid_fwd, 512, LDS_BYTES) != hipSuccess || per_cu < 1) { fprintf(stderr, "kernel_launch: occupancy query says %d\n", per_cu); per_cu = 1; }
        (void)hipGetLastError();
        grid = cus;
    }
    if (grid < 0) return;
    Params p{};
    p.x = (const float*)d_in[0]; p.mem = (const float*)d_in[1]; p.norm_g = (const float*)d_in[2]; p.mem_norm_g = (const float*)d_in[3];
    p.w_in = (const float*)d_in[4]; p.w_mem_kv = (const float*)d_in[5]; p.w_pool = (const float*)d_in[6]; p.pool_scale = (const float*)d_in[7];
    p.w_out = (const float*)d_in[8]; p.final_g = (const float*)d_in[9]; p.out = (float*)d_out; p.ws = (unsigned char*)d_ws;
    void* args[] = {&p};
    hipError_t e = hipLaunchCooperativeKernel((const void*)hybrid_fwd, dim3(grid), dim3(512), args, LDS_BYTES, stream);
    if (e != hipSuccess) fprintf(stderr, "cooperative launch failed: %s (grid %d)\n", hipGetErrorString(e), grid);
}
```

```cpp
#include <hip/hip_runtime.h>
#include <hip/hip_cooperative_groups.h>
#include <cstdio>
#include <cstdint>
namespace cg = cooperative_groups;
namespace pg8 {
#define PG8_LAS __attribute__((address_space(3)))
typedef unsigned short bf16_t;
typedef short bf16x8 __attribute__((ext_vector_type(8)));
typedef float f32x4 __attribute__((ext_vector_type(4)));
typedef unsigned u32x4 __attribute__((ext_vector_type(4)));
constexpr int BM = 256, BK = 64, HALF = 128, HTB = HALF * BK * 2  , STAGE_BYTES = 8 * HTB, NXCD = 8, WGM = 8;

__host__ __device__ __forceinline__ int lds_byte(int r, int c) { const int st = (r >> 4) * 2 + (c >> 5), rr = r & 15, cc = c & 31, ob = rr * 64 + cc * 2; return st * 1024 + (ob ^ (((ob >> 9) & 1) << 5)); }
__host__ __device__ __forceinline__ void stage_rc(int b, int& R, int& C) { const int st = b / 1024, sb = b % 1024, swz = sb ^ (((sb >> 9) & 1) << 5); R = (st >> 1) * 16 + swz / 64; C = (st & 1) * 32 + (swz % 64) / 2; }
__host__ __device__ __forceinline__ int perm32(int rho) { const int n = rho >> 4, i = rho & 15; return 8 * (i >> 2) + 4 * n + (i & 3); }

struct Unit { int pm, pn; };
struct Gemm { const bf16_t* A; const bf16_t* Bt; int M, N, K; };

struct StaticOrder {
    int nM, nN, nwg, G, c;
    __host__ __device__ void init(int M, int N, int G_, int c_) { nM = M / BM; nN = N / BM; nwg = nM * nN; G = G_; c = c_; }
    __host__ __device__ bool next(int i, Unit& u) const {
        const long L = (long)i * G + c; if (L >= nwg) return false;
        int wgid = (int)L; { const int q = nwg / NXCD, r = nwg % NXCD, xcd = wgid % NXCD, off = wgid / NXCD; wgid = (xcd < r ? xcd * (q + 1) : r * (q + 1) + (xcd - r) * q) + off; }
        const int nig = WGM * nN, gid = wgid / nig, fm = gid * WGM, gsz = (nM - fm) < WGM ? (nM - fm) : WGM;
        u.pm = fm + ((wgid % nig) % gsz); u.pn = (wgid % nig) / gsz; return true;
    }
    __device__ __forceinline__ void a_ready(const Unit&) const {}
    __device__ __forceinline__ void done(const Unit&) const {}
};

__device__ __forceinline__ unsigned cvt_pk_bf16(float lo, float hi) { unsigned r; asm volatile("v_cvt_pk_bf16_f32 %0, %1, %2" : "=v"(r) : "v"(lo), "v"(hi)); return r; }
typedef float f32x2 __attribute__((ext_vector_type(2)));
__device__ __forceinline__ f32x2 gelu_pk(f32x2 v) {
    const f32x2 av = __builtin_elementwise_abs(v), d = av * 0.2316418882f + 1.0f;
    f32x2 t; t.x = __builtin_amdgcn_rcpf(d.x); t.y = __builtin_amdgcn_rcpf(d.y);
    f32x2 q = t * 0.5307027145f + (-0.7265760135f); q = q * t + 0.7107068705f; q = q * t + (-0.142248368f); q = q * t + 0.127414796f; q = q * t;
    const f32x2 s = (v * v) * (-0.72134752044f);
    f32x2 e; e.x = __builtin_amdgcn_exp2f(s.x); e.y = __builtin_amdgcn_exp2f(s.y);
    const f32x2 m = v * (q * e), r = v - m;
    f32x2 o; o.x = v.x < 0.f ? m.x : r.x; o.y = v.y < 0.f ? m.y : r.y; return o;
}

template <int ACT  > struct EpiBf16 {
    static constexpr bool PERM = true, AFTER_DRAIN = false; static_assert(ACT == 0 || ACT == 1, "EpiBf16: ACT is 0 (none) or 1 (gelu_pk)");
    bf16_t* O; int ldc; const float* bias; int split_cols; size_t split_stride; float scale0;
    __device__ __forceinline__ void operator()(const f32x4 (&acc)[2][2][4][2], const Unit& u, int wr, int wc, int fr, int fq) const {
        const int row0 = u.pm * BM + wr * 64 + fr; int colt = u.pn * BM; bf16_t* base = O;
        float sc = 1.f; if (split_cols) { const int t = colt / split_cols; base += (size_t)t * split_stride; colt -= t * split_cols; if (t == 0) sc = scale0; }
        const int col0 = colt + wc * 32 + 8 * fq, bcol0 = u.pn * BM + wc * 32 + 8 * fq;
        f32x4 bv[2][2];
#pragma unroll
        for (int bj = 0; bj < 2; ++bj)
#pragma unroll
            for (int n = 0; n < 2; ++n) bv[bj][n] = bias ? *(const f32x4*)(bias + bcol0 + bj * HALF + 4 * n) : (f32x4){0.f, 0.f, 0.f, 0.f};
#pragma unroll
        for (int ai = 0; ai < 2; ++ai)
#pragma unroll
            for (int m = 0; m < 4; ++m) { bf16_t* rowp = base + (size_t)(row0 + ai * HALF + m * 16) * ldc + col0;
#pragma unroll
                for (int bj = 0; bj < 2; ++bj) { f32x4 v0 = acc[ai][bj][m][0] + bv[bj][0], v1 = acc[ai][bj][m][1] + bv[bj][1];
                    if (ACT == 1) { f32x2 a = gelu_pk((f32x2){v0[0], v0[1]}), b = gelu_pk((f32x2){v0[2], v0[3]}), c = gelu_pk((f32x2){v1[0], v1[1]}), d = gelu_pk((f32x2){v1[2], v1[3]});
                        v0 = (f32x4){a.x, a.y, b.x, b.y}; v1 = (f32x4){c.x, c.y, d.x, d.y}; }
                    v0 = v0 * sc; v1 = v1 * sc; u32x4 w; w.x = cvt_pk_bf16(v0[0], v0[1]); w.y = cvt_pk_bf16(v0[2], v0[3]); w.z = cvt_pk_bf16(v1[0], v1[1]); w.w = cvt_pk_bf16(v1[2], v1[3]);
                    *(u32x4*)(rowp + bj * HALF) = w; } }
    }
};
template <class Epi, class Sched, bool ALIGN_EPI = false, bool SP2 = false>
__device__ __forceinline__ void gemm_phase(PG8_LAS unsigned char* lds, const Gemm g, const Sched& S, const Epi& E) {
    const int tid = threadIdx.x, wid = __builtin_amdgcn_readfirstlane(tid >> 6), lane = tid & 63, wr = wid >> 2, wc = wid & 3, fr = lane & 15, fq = lane >> 4;
    const int K = g.K, nt = K / BK;
    unsigned voffA[2], voffB[2];
#pragma unroll
    for (int i = 0; i < 2; ++i) { int R, C; stage_rc(tid * 16 + i * 8192, R, C); const int Rb = Epi::PERM ? ((R & ~31) + perm32(R & 31)) : R;
        voffA[i] = (unsigned)(R * K + C) * 2u; voffB[i] = (unsigned)(Rb * K + C) * 2u; }
    const size_t kstep = (size_t)(BK * 2);
    const size_t hstep = (size_t)HALF * K * 2;
    const size_t tstep = 2 * hstep;
    const unsigned ldsw = (unsigned)wid * 1024u;
    const int aoff = lds_byte(wr * 64 + fr, fq * 8), boff = lds_byte(wc * 32 + fr, fq * 8);
#define PG8_SA(b, h) (((b) * 2 + (h)) * HTB)
#define PG8_SB(b, h) ((4 + (b) * 2 + (h)) * HTB)
#define PG8_STAGE(bufoff, gbase, voff) do { _Pragma("unroll") for (int _i = 0; _i < 2; ++_i) \
        __builtin_amdgcn_global_load_lds((const unsigned*)((const char*)(gbase) + (voff)[_i]), (PG8_LAS unsigned*)(lds + (bufoff) + ldsw + _i * 8192), 16, 0, 0); } while (0)
#define PG8_LDA(dst, b, h) do { _Pragma("unroll") for (int m = 0; m < 4; ++m) _Pragma("unroll") for (int k = 0; k < 2; ++k) dst[m][k] = *(const PG8_LAS bf16x8*)(lds + PG8_SA(b, h) + aoff + m * 2048 + k * 1024); } while (0)
#define PG8_LDB(dst, b, h) do { _Pragma("unroll") for (int n = 0; n < 2; ++n) _Pragma("unroll") for (int k = 0; k < 2; ++k) dst[n][k] = *(const PG8_LAS bf16x8*)(lds + PG8_SB(b, h) + boff + n * 2048 + k * 1024); } while (0)
#define PG8_MMA(ai, bj, At, Bt) do { __builtin_amdgcn_s_setprio(1); _Pragma("unroll") for (int m = 0; m < 4; ++m) _Pragma("unroll") for (int n = 0; n < 2; ++n) _Pragma("unroll") for (int k = 0; k < 2; ++k) \
        acc[ai][bj][m][n] = __builtin_amdgcn_mfma_f32_16x16x32_bf16(Bt[n][k], At[m][k], acc[ai][bj][m][n], 0, 0, 0); __builtin_amdgcn_s_setprio(0); } while (0)
#define PG8_WAIT_V(n) asm volatile("s_waitcnt vmcnt(" #n ")" ::: "memory")
#define PG8_WAIT_L(n) asm volatile("s_waitcnt lgkmcnt(" #n ")" ::: "memory")
#define PG8_BAR __builtin_amdgcn_s_barrier()
#define PG8_SCHED __builtin_amdgcn_sched_barrier(0)
    Unit cur, nxt; int ui = 0;
    if (!S.next(0, cur)) return;
    f32x4 acc[2][2][4][2];
#pragma unroll
    for (int a = 0; a < 2; ++a)
#pragma unroll
        for (int b = 0; b < 2; ++b)
#pragma unroll
            for (int m = 0; m < 4; ++m)
#pragma unroll
                for (int n = 0; n < 2; ++n) acc[a][b][m][n] = (f32x4){0.f, 0.f, 0.f, 0.f};
    bf16x8 At[4][2], B0[2][2], B1[2][2];
    const char* cA = (const char*)g.A + (size_t)cur.pm * tstep; const char* cB = (const char*)g.Bt + (size_t)cur.pn * tstep;
    S.a_ready(cur);
    if constexpr (SP2) {
        PG8_STAGE(PG8_SB(0, 0), cB, voffB); PG8_STAGE(PG8_SB(0, 1), cB + hstep, voffB); PG8_STAGE(PG8_SA(0, 0), cA, voffA); PG8_STAGE(PG8_SA(0, 1), cA + hstep, voffA);
        if (wr == 1) PG8_BAR;
        PG8_WAIT_V(2); PG8_BAR;
        PG8_STAGE(PG8_SB(1, 0), cB + kstep, voffB); PG8_STAGE(PG8_SA(1, 0), cA + kstep, voffA); PG8_STAGE(PG8_SB(1, 1), cB + hstep + kstep, voffB);
        PG8_WAIT_V(6); PG8_BAR;
    } else {
        PG8_STAGE(PG8_SB(0, 0), cB, voffB); PG8_STAGE(PG8_SA(0, 0), cA, voffA); PG8_STAGE(PG8_SB(0, 1), cB + hstep, voffB); PG8_STAGE(PG8_SA(0, 1), cA + hstep, voffA);
        if (wr == 1) PG8_BAR;
        PG8_WAIT_V(4); PG8_BAR;
        PG8_STAGE(PG8_SB(1, 0), cB + kstep, voffB); PG8_STAGE(PG8_SA(1, 0), cA + kstep, voffA); PG8_STAGE(PG8_SB(1, 1), cB + hstep + kstep, voffB);
        PG8_WAIT_V(6); PG8_BAR;
    }
    for (;;) {
        const bool has_next = S.next(ui + 1, nxt);
        const char* nA = has_next ? (const char*)g.A + (size_t)nxt.pm * tstep : cA; const char* nB = has_next ? (const char*)g.Bt + (size_t)nxt.pn * tstep : cB;
        for (int t = 0; t < nt; t += 2) {
            const bool last = (t == nt - 2);
            const char* a1 = cA + (size_t)(t + 1) * kstep;
            const char* a2 = last ? nA : cA + (size_t)(t + 2) * kstep; const char* b2 = last ? nB : cB + (size_t)(t + 2) * kstep;
            const char* a3 = a2 + kstep; const char* b3 = b2 + kstep;
            if (last && has_next) S.a_ready(nxt);
            if constexpr (SP2) {
            PG8_LDB(B0, 0, 0); PG8_LDB(B1, 0, 1); PG8_SCHED; PG8_LDA(At, 0, 0); PG8_STAGE(PG8_SA(1, 1), a1 + hstep, voffA);
            PG8_WAIT_V(8); PG8_WAIT_L(0); PG8_BAR; PG8_MMA(0, 0, At, B0); PG8_MMA(0, 1, At, B1); PG8_BAR; PG8_SCHED;
            PG8_LDA(At, 0, 1); PG8_STAGE(PG8_SB(0, 0), b2, voffB); PG8_STAGE(PG8_SB(0, 1), b2 + hstep, voffB); PG8_STAGE(PG8_SA(0, 0), a2, voffA);
            PG8_WAIT_V(8); PG8_WAIT_L(0); PG8_BAR; PG8_MMA(1, 0, At, B0); PG8_MMA(1, 1, At, B1); PG8_BAR; PG8_SCHED;
            PG8_LDB(B0, 1, 0); PG8_LDB(B1, 1, 1); PG8_SCHED; PG8_LDA(At, 1, 0); PG8_STAGE(PG8_SA(0, 1), a2 + hstep, voffA);
            PG8_WAIT_V(8); PG8_WAIT_L(0); PG8_BAR; PG8_MMA(0, 0, At, B0); PG8_MMA(0, 1, At, B1); PG8_BAR; PG8_SCHED;
            PG8_LDA(At, 1, 1); PG8_STAGE(PG8_SB(1, 0), b3, voffB); PG8_STAGE(PG8_SB(1, 1), b3 + hstep, voffB); PG8_STAGE(PG8_SA(1, 0), a3, voffA);
            PG8_WAIT_V(8); PG8_WAIT_L(0); PG8_BAR; PG8_MMA(1, 0, At, B0); PG8_MMA(1, 1, At, B1); PG8_BAR; PG8_SCHED;
            } else {
            PG8_LDB(B0, 0, 0); PG8_SCHED; PG8_LDA(At, 0, 0); PG8_STAGE(PG8_SA(1, 1), a1 + hstep, voffA);
            PG8_WAIT_L(8); PG8_BAR; PG8_WAIT_L(0); PG8_MMA(0, 0, At, B0); PG8_BAR; PG8_SCHED;
            PG8_LDB(B1, 0, 1); PG8_STAGE(PG8_SB(0, 0), b2, voffB);
            PG8_BAR; PG8_WAIT_L(0); PG8_MMA(0, 1, At, B1); PG8_BAR;
            PG8_LDA(At, 0, 1); PG8_STAGE(PG8_SA(0, 0), a2, voffA);
            PG8_BAR; PG8_WAIT_L(0); PG8_MMA(1, 0, At, B0); PG8_BAR; PG8_SCHED;
            PG8_STAGE(PG8_SB(0, 1), b2 + hstep, voffB);
            PG8_WAIT_V(6); PG8_BAR; PG8_MMA(1, 1, At, B1); PG8_BAR;
            PG8_LDB(B0, 1, 0); PG8_SCHED; PG8_LDA(At, 1, 0); PG8_STAGE(PG8_SA(0, 1), a2 + hstep, voffA);
            PG8_WAIT_L(8); PG8_BAR; PG8_WAIT_L(0); PG8_MMA(0, 0, At, B0); PG8_BAR; PG8_SCHED;
            PG8_LDB(B1, 1, 1); PG8_STAGE(PG8_SB(1, 0), b3, voffB);
            PG8_BAR; PG8_WAIT_L(0); PG8_MMA(0, 1, At, B1); PG8_BAR;
            PG8_LDA(At, 1, 1); PG8_STAGE(PG8_SA(1, 0), a3, voffA);
            PG8_BAR; PG8_WAIT_L(0); PG8_MMA(1, 0, At, B0); PG8_BAR; PG8_SCHED;
            PG8_STAGE(PG8_SB(1, 1), b3 + hstep, voffB);
            PG8_WAIT_V(6); PG8_BAR; PG8_MMA(1, 1, At, B1); PG8_BAR;
            }
        }
        if constexpr (ALIGN_EPI) { if (wr == 0) PG8_BAR; }
        if constexpr (!Epi::AFTER_DRAIN) { E(acc, cur, wr, wc, fr, fq); S.done(cur); }
        if (!has_next) break;
#pragma unroll
        for (int a = 0; a < 2; ++a)
#pragma unroll
            for (int b = 0; b < 2; ++b)
#pragma unroll
                for (int m = 0; m < 4; ++m)
#pragma unroll
                    for (int n = 0; n < 2; ++n) acc[a][b][m][n] = (f32x4){0.f, 0.f, 0.f, 0.f};
        cur = nxt; cA = nA; cB = nB; ++ui;
        if constexpr (ALIGN_EPI) { if (wr == 1) PG8_BAR; }
    }
    PG8_WAIT_V(0);
    if constexpr (!ALIGN_EPI) { if (wr == 0) PG8_BAR; }
    PG8_BAR;
    if constexpr (Epi::AFTER_DRAIN) { E.fused(acc, cur, wr, wc, fr, fq, lds, wid, lane); S.done(cur); }
#undef PG8_SA
#undef PG8_SB
#undef PG8_STAGE
#undef PG8_LDA
#undef PG8_LDB
#undef PG8_MMA
#undef PG8_WAIT_V
#undef PG8_WAIT_L
#undef PG8_BAR
#undef PG8_SCHED
}
}
constexpr int BATCH = 2, SEQ = 8192, DM = 2048, NTOK = BATCH * SEQ, DIN = 6144, MEML = 256;
constexpr int NH = 8, HD = 128, NHM = 4, NBLK = 32, BLK = 256;
constexpr int ZQ = 0, ZK = 1024, ZV = 2048, ZGA = 3072, ZU = 4096, ZGP = 4608, ZQM = 5120, ZGM = 5632;
constexpr float EPS = 1e-6f;
constexpr float SM_C = 0.08838834764831845f * 1.4426950408889634f;

constexpr size_t MiB = 1u << 20;
constexpr size_t WS_CNT = 0; constexpr size_t WS_BAR = 524288, BAR_BYTES = 16384;
constexpr int MISC_OFF = 147456 - 64;
constexpr size_t WS_KMH = 1 * MiB, WS_KML = WS_KMH + 131072, WS_WPT = WS_KML + 131072;
constexpr size_t WS_MK = 2 * MiB;
constexpr size_t WS_MVT = 3 * MiB;
constexpr size_t WS_MEMH = 4 * MiB;
constexpr size_t WS_WMEMT = 6 * MiB;
constexpr size_t WS_WOUTT = 10 * MiB;
constexpr size_t WS_WINT = 18 * MiB;
constexpr size_t WS_LIST = 42 * MiB;
constexpr size_t WS_ML = 58 * MiB;
constexpr size_t WS_H = 64 * MiB;
constexpr size_t WS_Y = WS_H;
constexpr size_t WS_Z = 128 * MiB;
constexpr size_t WS_VT = 320 * MiB;
constexpr size_t WS_OP = 352 * MiB;
constexpr size_t WS_END = 448 * MiB;

constexpr int LDS_BYTES = 147456;
constexpr int KL_OFF = 0, KL_STRIDE = 272, VL_OFF = 256 * KL_STRIDE, VL_STRIDE = 528, PRE_OFF = VL_OFF + 128 * VL_STRIDE;
static_assert(PRE_OFF + 520 * 4 + 64 <= LDS_BYTES, "lds map");

#define LAS __attribute__((address_space(3)))
typedef unsigned short bf16;
typedef short bf16x8 __attribute__((ext_vector_type(8)));
typedef float f32x4 __attribute__((ext_vector_type(4)));
typedef float f32x16 __attribute__((ext_vector_type(16)));
typedef unsigned u32x4 __attribute__((ext_vector_type(4)));
typedef unsigned u32x2 __attribute__((ext_vector_type(2)));
typedef float f32x2_t __attribute__((ext_vector_type(2)));
typedef __bf16 bf16x2_t __attribute__((ext_vector_type(2)));
#define DI __device__ __forceinline__
DI unsigned cvtpk(float lo, float hi) { f32x2_t v = {lo, hi}; bf16x2_t b = __builtin_convertvector(v, bf16x2_t); return __builtin_bit_cast(unsigned, b); }
DI float bflo(unsigned u) { return __uint_as_float(u << 16); }
DI float bfhi(unsigned u) { return __uint_as_float(u & 0xffff0000u); }
DI float wave_sum(float v) {
#pragma unroll
    for (int o = 1; o < 64; o <<= 1) v += __shfl_xor(v, o);
    return v;
}
DI int crow(int i, int h) { return (i & 3) + 8 * (i >> 2) + 4 * h; }
DI int pi32(int r) { return (r & ~12) | ((r & 4) << 1) | ((r & 8) >> 1); }
DI float silu(float g) { return g / (1.0f + __expf(-g)); }
#define MFMA32(a, b, c) __builtin_amdgcn_mfma_f32_32x32x16_bf16((a), (b), (c), 0, 0, 0)

struct Params {
    const float *x, *mem, *norm_g, *mem_norm_g, *w_in, *w_mem_kv, *w_pool, *pool_scale, *w_out, *final_g;
    float* out; unsigned char* ws;
};

struct EpiResF32 {
    static constexpr bool PERM = false, AFTER_DRAIN = false;
    const float* base; float* out; int ldc;
    __device__ __forceinline__ void operator()(const pg8::f32x4 (&acc)[2][2][4][2], const pg8::Unit& u, int wr, int wc, int fr, int fq) const {
        const int col0 = u.pn * pg8::BM + wc * 32 + 4 * fq;
#pragma unroll
        for (int ai = 0; ai < 2; ++ai)
#pragma unroll
            for (int m = 0; m < 4; ++m) {
                const size_t off = (size_t)(u.pm * pg8::BM + ai * pg8::HALF + wr * 64 + m * 16 + fr) * ldc + col0;
#pragma unroll
                for (int bj = 0; bj < 2; ++bj)
#pragma unroll
                    for (int n = 0; n < 2; ++n) {
                        const pg8::f32x4 b = *(const pg8::f32x4*)(base + off + bj * pg8::HALF + n * 16);
                        *(pg8::f32x4*)(out + off + bj * pg8::HALF + n * 16) = acc[ai][bj][m][n] + b;
                    }
            }
    }
};
struct EpiZ {
    static constexpr bool PERM = true, AFTER_DRAIN = false;
    bf16* O; int ldc;
    __device__ __forceinline__ void operator()(const pg8::f32x4 (&acc)[2][2][4][2], const pg8::Unit& u, int wr, int wc, int fr, int fq) const {
        const int row0 = u.pm * pg8::BM + wr * 64 + fr; const int col0 = u.pn * pg8::BM + wc * 32 + 8 * fq;
#pragma unroll
        for (int ai = 0; ai < 2; ++ai)
#pragma unroll
            for (int m = 0; m < 4; ++m) { bf16* rowp = O + (size_t)(row0 + ai * pg8::HALF + m * 16) * ldc + col0;
#pragma unroll
                for (int bj = 0; bj < 2; ++bj) { const pg8::f32x4 v0 = acc[ai][bj][m][0], v1 = acc[ai][bj][m][1];
                    u32x4 w; w.x = cvtpk(v0[0], v0[1]); w.y = cvtpk(v0[2], v0[3]); w.z = cvtpk(v1[0], v1[1]); w.w = cvtpk(v1[2], v1[3]);
                    *(u32x4*)(rowp + bj * pg8::HALF) = w; } }
    }
};

DI void transpose_item(const float* W, int K, int N, bf16* WT, LAS float* scr, int item, int lane) {
    const int nblk = N / 32, kb = item / nblk, nb = item % nblk, k0 = 64 * kb, n0 = 32 * nb;
#pragma unroll 8
    for (int i = 0; i < 32; ++i) { const int kk = 2 * i + (lane >> 5); scr[kk * 33 + (lane & 31)] = W[(size_t)(k0 + kk) * N + n0 + (lane & 31)]; }
    __builtin_amdgcn_fence(__ATOMIC_RELEASE, "wavefront"); asm volatile("s_waitcnt lgkmcnt(0)" ::: "memory");
    const int c = lane & 7;
#pragma unroll
    for (int j = 0; j < 4; ++j) { const int n = (lane >> 3) + 8 * j; const LAS float* s = scr + (8 * c) * 33 + n;
        u32x4 o; o.x = cvtpk(s[0 * 33], s[1 * 33]); o.y = cvtpk(s[2 * 33], s[3 * 33]); o.z = cvtpk(s[4 * 33], s[5 * 33]); o.w = cvtpk(s[6 * 33], s[7 * 33]);
        *(u32x4*)(WT + (size_t)(n0 + n) * K + k0 + 8 * c) = o; }
    asm volatile("s_waitcnt lgkmcnt(0)" ::: "memory");
}
DI void rms_row_bf16(const float* xrow, const float* g, bf16* orow, int lane) {
    const f32x4* xr = (const f32x4*)xrow + lane; const f32x4* gr = (const f32x4*)g + lane;
    f32x4 v[8]; float s = 0.f;
#pragma unroll
    for (int j = 0; j < 8; ++j) { v[j] = xr[64 * j]; s += (v[j].x * v[j].x + v[j].y * v[j].y) + (v[j].z * v[j].z + v[j].w * v[j].w); }
    const float rstd = 1.0f / sqrtf(wave_sum(s) * (1.f / DM) + EPS);
    u32x2* o8 = (u32x2*)orow + lane;
#pragma unroll
    for (int j = 0; j < 8; ++j) { const f32x4 gg = gr[64 * j]; u32x2 w; w.x = cvtpk(v[j].x * rstd * gg.x, v[j].y * rstd * gg.y); w.y = cvtpk(v[j].z * rstd * gg.z, v[j].w * rstd * gg.w); o8[64 * j] = w; }
}
DI void rms_row_f32(float* row, const float* g, int lane) {
    f32x4* xr = (f32x4*)row + lane; const f32x4* gr = (const f32x4*)g + lane;
    f32x4 v[8]; float s = 0.f;
#pragma unroll
    for (int j = 0; j < 8; ++j) { v[j] = xr[64 * j]; s += (v[j].x * v[j].x + v[j].y * v[j].y) + (v[j].z * v[j].z + v[j].w * v[j].w); }
    const float rstd = 1.0f / sqrtf(wave_sum(s) * (1.f / DM) + EPS);
#pragma unroll
    for (int j = 0; j < 8; ++j) { const f32x4 gg = gr[64 * j]; xr[64 * j] = v[j] * rstd * gg; }
}

DI void attn_core(const LAS unsigned char* lds, const bf16x8 (&qf)[8], int ntiles, bool causal, int qlocal, int r, int hh, f32x16 (&o)[4], float& m, float& l) {
    m = -1e30f; l = 0.f;
#pragma unroll
    for (int dt = 0; dt < 4; ++dt)
#pragma unroll
        for (int i = 0; i < 16; ++i) o[dt][i] = 0.f;
    const LAS unsigned char* kbase = lds + KL_OFF + pi32(r) * KL_STRIDE + 16 * hh;
    const LAS unsigned char* vbase = lds + VL_OFF + r * VL_STRIDE + 16 * hh;
    for (int kt = 0; kt < ntiles; ++kt) {
        f32x16 s;
#pragma unroll
        for (int i = 0; i < 16; ++i) s[i] = 0.f;
        const LAS unsigned char* kp = kbase + kt * 32 * KL_STRIDE;
#pragma unroll
        for (int d0 = 0; d0 < 8; ++d0) { const bf16x8 kf = *(const LAS bf16x8*)(kp + 32 * d0); s = MFMA32(kf, qf[d0], s); }
        if (causal) {
#pragma unroll
            for (int i = 0; i < 16; ++i) { const int kl = 32 * kt + 16 * (i >> 3) + 8 * hh + (i & 7); if (kl > qlocal) s[i] = -INFINITY; }
        }
        float mx = s[0];
#pragma unroll
        for (int i = 1; i < 16; ++i) mx = fmaxf(mx, s[i]);
        mx = fmaxf(mx, __shfl_xor(mx, 32));
        const float mn = fmaxf(m, mx);
        const float alpha = __builtin_amdgcn_exp2f((m - mn) * SM_C);
        const float mnc = mn * SM_C;
        float ps = 0.f;
#pragma unroll
        for (int i = 0; i < 16; ++i) { s[i] = __builtin_amdgcn_exp2f(s[i] * SM_C - mnc); ps += s[i]; }
        l = l * alpha + ps; m = mn;
#pragma unroll
        for (int dt = 0; dt < 4; ++dt)
#pragma unroll
            for (int i = 0; i < 16; ++i) o[dt][i] *= alpha;
        u32x4 p0, p1;
        p0.x = cvtpk(s[0], s[1]); p0.y = cvtpk(s[2], s[3]); p0.z = cvtpk(s[4], s[5]); p0.w = cvtpk(s[6], s[7]);
        p1.x = cvtpk(s[8], s[9]); p1.y = cvtpk(s[10], s[11]); p1.z = cvtpk(s[12], s[13]); p1.w = cvtpk(s[14], s[15]);
        const bf16x8 pb0 = __builtin_bit_cast(bf16x8, p0), pb1 = __builtin_bit_cast(bf16x8, p1);
        const LAS unsigned char* vp = vbase + kt * 64;
#pragma unroll
        for (int dt = 0; dt < 4; ++dt) {
            const bf16x8 v0 = *(const LAS bf16x8*)(vp + dt * 32 * VL_STRIDE);
            const bf16x8 v1 = *(const LAS bf16x8*)(vp + dt * 32 * VL_STRIDE + 32);
            o[dt] = MFMA32(v0, pb0, o[dt]);
            o[dt] = MFMA32(v1, pb1, o[dt]);
        }
    }
}
DI void load_kv(LAS unsigned char* lds, const bf16* Kg, size_t kstride, const bf16* Vg, size_t vstride, int tid) {
#pragma unroll
    for (int it = 0; it < 8; ++it) { const int id = tid + 512 * it, row = id >> 4, ch = id & 15;
        const u32x4 v = *(const u32x4*)(Kg + (size_t)row * kstride + ch * 8); *(LAS u32x4*)(lds + KL_OFF + row * KL_STRIDE + ch * 16) = v; }
#pragma unroll
    for (int it = 0; it < 8; ++it) { const int id = tid + 512 * it, d = id >> 5, ch = id & 31;
        const u32x4 v = *(const u32x4*)(Vg + (size_t)d * vstride + ch * 8); *(LAS u32x4*)(lds + VL_OFF + d * VL_STRIDE + ch * 16) = v; }
}
DI void load_q(bf16x8 (&qf)[8], const bf16* qrow, int hh) {
#pragma unroll
    for (int d0 = 0; d0 < 8; ++d0) qf[d0] = *(const bf16x8*)(qrow + 16 * d0 + 8 * hh);
}

typedef __attribute__((address_space(1))) unsigned gu32;
#define XB_TMO      128
#define XB_XCNT(j)  (256  + 64 * (j))
#define XB_XSUB(j)  (1280 + 64 * (j))
#define XB_XGEN(j)  (2304 + 64 * (j))
#define XB_TOP      3328
#define XB_TOPGEN   3392
#define XCD_BAR_WORDS 3456
#define XB_SPIN_CAP (1u << 18)

__device__ __forceinline__ unsigned xb_ld(unsigned* p)              { return __hip_atomic_load(p, __ATOMIC_RELAXED, __HIP_MEMORY_SCOPE_AGENT); }
__device__ __forceinline__ unsigned xb_add(unsigned* p, unsigned v) { return __hip_atomic_fetch_add(p, v, __ATOMIC_RELAXED, __HIP_MEMORY_SCOPE_AGENT); }
__device__ __forceinline__ unsigned xb_xcc_id() { return (unsigned)__builtin_amdgcn_s_getreg((3 << 11) | 20) & 0xFu; }
#define XB_SPIN(cond, bar) do { unsigned _sp = 0; while (cond) { __builtin_amdgcn_s_sleep(1); \
    if ((++_sp & 255u) == 0u) { if (xb_ld(&(bar)[XB_TMO])) break; if (_sp > XB_SPIN_CAP) { atomicAdd(&(bar)[XB_TMO], 1u); break; } } } } while (0)

struct XcdBarrier {
    unsigned* bar; unsigned x;
    volatile LAS unsigned* st;
};

__device__ __forceinline__ XcdBarrier xcd_barrier_post(unsigned* bar, volatile LAS unsigned* st) {
    XcdBarrier b; b.bar = bar; b.x = xb_xcc_id(); b.st = st;
    if (threadIdx.x == 0) (void)xb_add(&bar[XB_XCNT(b.x)], 1u);
    return b;
}
__device__ __forceinline__ void xcd_barrier_complete(unsigned* bar, unsigned x, unsigned& nloc, unsigned& nx) {
    const unsigned G = gridDim.x * gridDim.y * gridDim.z;
    unsigned sum, cnt, mine, sp = 0u;
    for (;;) {
        sum = 0u; cnt = 0u; mine = 0u;
#pragma unroll
        for (unsigned j = 0; j < 16; ++j) { const unsigned c = xb_ld(&bar[XB_XCNT(j)]); sum += c; cnt += (c > 0u) ? 1u : 0u; mine = (j == x) ? c : mine; }
        if (sum == G) break;
        __builtin_amdgcn_s_sleep(1);
        if ((++sp & 255u) == 0u) { if (xb_ld(&bar[XB_TMO])) break; if (sp > XB_SPIN_CAP) { atomicAdd(&bar[XB_TMO], 1u); break; } }
    }
    nloc = mine > 0u ? mine : 1u; nx = cnt > 0u ? cnt : 1u;
}

__device__ __forceinline__ void xcd_barrier(const XcdBarrier& b) {
    asm volatile("s_waitcnt vmcnt(0)" ::: "memory");
    __syncthreads();
    if (threadIdx.x == 0) {
        unsigned* bar = b.bar;
        __builtin_amdgcn_s_waitcnt(0);
        unsigned nloc = b.st[0], nx = b.st[1];
        if (nloc == 0u) { xcd_barrier_complete(bar, b.x, nloc, nx); b.st[0] = nloc; b.st[1] = nx; }
        const unsigned old = xb_add(&bar[XB_XSUB(b.x)], 1u);
        const unsigned gen = old / nloc;
        if (old + 1u == (gen + 1u) * nloc) {
            __builtin_amdgcn_fence(__ATOMIC_RELEASE, "agent");
            asm volatile("s_waitcnt vmcnt(0)" ::: "memory");
            const unsigned og = xb_add(&bar[XB_TOP], 1u);
            const unsigned tg = og / nx;
            if (og + 1u == (tg + 1u) * nx) xb_add(&bar[XB_TOPGEN], 1u);
            else XB_SPIN(xb_ld(&bar[XB_TOPGEN]) == tg, bar);
            __builtin_amdgcn_fence(__ATOMIC_ACQUIRE, "agent");
            xb_add(&bar[XB_XGEN(b.x)], 1u);
            asm volatile("s_waitcnt vmcnt(0)" ::: "memory");
        } else {
            XB_SPIN(xb_ld(&bar[XB_XGEN(b.x)]) == gen, bar);
            __builtin_amdgcn_fence(__ATOMIC_ACQUIRE, "agent");
            asm volatile("s_waitcnt vmcnt(0)" ::: "memory");
        }
    }
    __syncthreads();
}

__global__ void __launch_bounds__(512, 2) hybrid_fwd(Params p) {
    extern __shared__ __attribute__((aligned(16))) unsigned char lds_raw[];
    LAS unsigned char* lds = (LAS unsigned char*)lds_raw;
    cg::grid_group grid = cg::this_grid();
    const int tid = threadIdx.x, lane = tid & 63, wave = __builtin_amdgcn_readfirstlane(tid >> 6);
    const int G = gridDim.x, bx = blockIdx.x;
    const int gw = bx * 8 + wave, NGW = G * 8;
    const int r = lane & 31, hh = lane >> 5;
    unsigned char* ws = p.ws;
    if (tid < 16) ((LAS unsigned*)(lds + MISC_OFF))[tid] = 0u;
    __syncthreads();
    XcdBarrier bar = xcd_barrier_post((unsigned*)(ws + WS_BAR), (volatile LAS unsigned*)(lds + MISC_OFF));
    unsigned* gcount = (unsigned*)(ws + WS_CNT);
    bf16* KMH = (bf16*)(ws + WS_KMH); bf16* KML = (bf16*)(ws + WS_KML); bf16* WPT = (bf16*)(ws + WS_WPT);
    bf16* MK = (bf16*)(ws + WS_MK); bf16* MVT = (bf16*)(ws + WS_MVT); bf16* MEMH = (bf16*)(ws + WS_MEMH);
    bf16* WMEMT = (bf16*)(ws + WS_WMEMT); bf16* WOUTT = (bf16*)(ws + WS_WOUTT); bf16* WINT = (bf16*)(ws + WS_WINT);
    unsigned* LIST = (unsigned*)(ws + WS_LIST); f32x2_t* MLB = (f32x2_t*)(ws + WS_ML);
    bf16* H = (bf16*)(ws + WS_H); bf16* Y = (bf16*)(ws + WS_Y); bf16* Z = (bf16*)(ws + WS_Z); bf16* VT = (bf16*)(ws + WS_VT); bf16* OP = (bf16*)(ws + WS_OP);

    {
        LAS float* scr = (LAS float*)(lds + wave * 16384);
        constexpr int I_IN = (DM / 64) * (DIN / 32), I_OUT = (DM / 64) * (DM / 32), I_MEM = (DM / 64) * (1024 / 32), I_POOL = 4 * 2 * 4;
        constexpr int NIT = I_IN + I_OUT + I_MEM + I_POOL;
        for (int it = gw; it < NIT; it += NGW) {
            int q = it;
            if (q < I_IN) { transpose_item(p.w_in, DM, DIN, WINT, scr, q, lane); continue; } q -= I_IN;
            if (q < I_OUT) { transpose_item(p.w_out, DM, DM, WOUTT, scr, q, lane); continue; } q -= I_OUT;
            if (q < I_MEM) { transpose_item(p.w_mem_kv, DM, 1024, WMEMT, scr, q, lane); continue; } q -= I_MEM;
            { const int g = q >> 3; transpose_item(p.w_pool + g * 16384, 128, 128, WPT + g * 16384, scr, q & 7, lane); }
        }
        for (int m = gw; m < NTOK + BATCH * MEML; m += NGW) {
            if (m < NTOK) rms_row_bf16(p.x + (size_t)m * DM, p.norm_g, H + (size_t)m * DM, lane);
            else { const int mm = m - NTOK; rms_row_bf16(p.mem + (size_t)mm * DM, p.mem_norm_g, MEMH + (size_t)mm * DM, lane); }
        }
        if (bx == 0) gcount[tid] = 0u;
    }
    grid.sync();

    {
        pg8::Gemm g{H, WINT, NTOK, DIN, DM}; pg8::StaticOrder S; S.init(NTOK, DIN, G, bx);
        EpiZ E{Z, DIN};
        pg8::gemm_phase<EpiZ, pg8::StaticOrder, true, true>(lds, g, S, E);
    }
    xcd_barrier(bar);

    {
        for (int tt = gw; tt < 32 * 64; tt += NGW) {
            const int tr = tt >> 6, tc = tt & 63, row = lane & 15, quad = lane >> 4;
            const bf16* ap = MEMH + (size_t)(16 * tr + row) * DM + quad * 8;
            const bf16* bp = WMEMT + (size_t)(16 * tc + row) * DM + quad * 8;
            f32x4 acc = {0.f, 0.f, 0.f, 0.f};
#pragma unroll 8
            for (int k0 = 0; k0 < DM; k0 += 32) {
                const bf16x8 a = *(const bf16x8*)(ap + k0), b = *(const bf16x8*)(bp + k0);
                acc = __builtin_amdgcn_mfma_f32_16x16x32_bf16(a, b, acc, 0, 0, 0);
            }
            const int gc = 16 * tc + row, gr0 = 16 * tr + quad * 4;
            if (gc < 512) {
#pragma unroll
                for (int j = 0; j < 4; ++j) MK[(size_t)(gr0 + j) * 512 + gc] = (bf16)(cvtpk(acc[j], 0.f) & 0xffffu);
            } else {
                const int dc = gc - 512, hm = dc >> 7, d = dc & 127, b = gr0 >> 8, m0 = gr0 & 255;
                u32x2 w; w.x = cvtpk(acc[0], acc[1]); w.y = cvtpk(acc[2], acc[3]);
                *(u32x2*)(MVT + ((size_t)((b * NHM + hm) * 128 + d)) * 256 + m0) = w;
            }
        }
        LAS unsigned* vt32 = (LAS unsigned*)lds;
        LAS bf16* vt16 = (LAS bf16*)lds;
        LAS float* ksum = (LAS float*)(lds + 256 * 65 * 4);
        for (int item = bx; item < BATCH * NH * NBLK; item += G) {
            const int j = item & 31, h = (item >> 5) & 7, b = item >> 8;
            const size_t tok0 = (size_t)b * SEQ + (size_t)j * BLK;
            {
                const int c2 = tid & 63, w = tid >> 6;
                float a0 = 0.f, a1 = 0.f;
                const bf16* kp = Z + (tok0 + 32 * w) * DIN + ZK + h * HD + 2 * c2;
#pragma unroll 8
                for (int rr = 0; rr < 32; ++rr) { const unsigned u = *(const unsigned*)(kp + (size_t)rr * DIN); a0 += bflo(u); a1 += bfhi(u); }
                ksum[w * 128 + 2 * c2] = a0; ksum[w * 128 + 2 * c2 + 1] = a1;
            }
#pragma unroll
            for (int it = 0; it < 8; ++it) { const int id = tid + 512 * it, row = id >> 4, ch = id & 15;
                const u32x4 v = *(const u32x4*)(Z + (tok0 + row) * DIN + ZV + h * HD + ch * 8);
                LAS unsigned* d = vt32 + row * 65 + ch * 4; d[0] = v.x; d[1] = v.y; d[2] = v.z; d[3] = v.w; }
            __syncthreads();
            if (tid < 128) {
                float s = 0.f;
#pragma unroll
                for (int w = 0; w < 8; ++w) s += ksum[w * 128 + tid];
                s *= (1.0f / 256.0f);
                const unsigned hi = cvtpk(s, 0.f) & 0xffffu; const float lo = s - __uint_as_float(hi << 16);
                KMH[(size_t)item * 128 + tid] = (bf16)hi; KML[(size_t)item * 128 + tid] = (bf16)(cvtpk(lo, 0.f) & 0xffffu);
            }
#pragma unroll
            for (int it = 0; it < 8; ++it) { const int d = (tid >> 5) + 16 * it, kc = tid & 31;
                unsigned e[8];
#pragma unroll
                for (int jj = 0; jj < 8; ++jj) e[jj] = vt16[(8 * kc + jj) * 130 + d];
                u32x4 o; o.x = e[0] | (e[1] << 16); o.y = e[2] | (e[3] << 16); o.z = e[4] | (e[5] << 16); o.w = e[6] | (e[7] << 16);
                *(u32x4*)(VT + ((size_t)((b * NH + h) * 128 + d)) * SEQ + j * BLK + 8 * kc) = o; }
            __syncthreads();
        }
    }
    xcd_barrier(bar);

    {
        LAS float* gl = (LAS float*)lds;
        LAS unsigned* lcnt = (LAS unsigned*)(lds + 8 * 32 * 33 * 4);
        LAS unsigned* lbase = lcnt + 32;
        for (int item = bx; item < BATCH * NH * NBLK; item += G) {
            const int i = item & 31, h = (item >> 5) & 7, b = item >> 8, bh = item >> 5;
            if (i == 0) continue;
            const int s_q = i * BLK + wave * 32 + r;
            bf16x8 qf[8]; load_q(qf, Z + ((size_t)b * SEQ + s_q) * DIN + ZQ + h * HD, hh);
            f32x16 acc;
#pragma unroll
            for (int ii = 0; ii < 16; ++ii) acc[ii] = 0.f;
            const bf16* kmh = KMH + ((size_t)(bh * 32 + r)) * 128 + 8 * hh; const bf16* kml = KML + ((size_t)(bh * 32 + r)) * 128 + 8 * hh;
#pragma unroll
            for (int d0 = 0; d0 < 8; ++d0) { const bf16x8 a = *(const bf16x8*)(kmh + 16 * d0); acc = MFMA32(a, qf[d0], acc); }
#pragma unroll
            for (int d0 = 0; d0 < 8; ++d0) { const bf16x8 a = *(const bf16x8*)(kml + 16 * d0); acc = MFMA32(a, qf[d0], acc); }
#pragma unroll
            for (int ii = 0; ii < 16; ++ii) gl[(wave * 32 + r) * 33 + crow(ii, hh)] = acc[ii];
            if (tid < 32) lcnt[tid] = 0u;
            __syncthreads();
            int i0 = -1, i1 = -1, i2 = -1; unsigned r0 = 0, r1 = 0, r2 = 0;
            if (hh == 0) {
                float v0 = -INFINITY, v1 = -INFINITY, v2 = -INFINITY;
                const LAS float* gp = gl + (wave * 32 + r) * 33;
                for (int n = 0; n < i; ++n) {
                    const float v = gp[n];
                    if (v > v0) { v2 = v1; i2 = i1; v1 = v0; i1 = i0; v0 = v; i0 = n; }
                    else if (v > v1) { v2 = v1; i2 = i1; v1 = v; i1 = n; }
                    else if (v > v2) { v2 = v; i2 = n; }
                }
                if (i0 >= 0) r0 = atomicAdd((unsigned*)(lcnt + i0), 1u);
                if (i1 >= 0) r1 = atomicAdd((unsigned*)(lcnt + i1), 1u);
                if (i2 >= 0) r2 = atomicAdd((unsigned*)(lcnt + i2), 1u);
            }
            __syncthreads();
            if (tid < i) lbase[tid] = atomicAdd(gcount + bh * 32 + tid, lcnt[tid]);
            __syncthreads();
            if (hh == 0) {
                if (i0 >= 0) LIST[(size_t)(bh * 32 + i0) * 8192 + lbase[i0] + r0] = (unsigned)s_q;
                if (i1 >= 0) LIST[(size_t)(bh * 32 + i1) * 8192 + lbase[i1] + r1] = (unsigned)s_q | (1u << 16);
                if (i2 >= 0) LIST[(size_t)(bh * 32 + i2) * 8192 + lbase[i2] + r2] = (unsigned)s_q | (2u << 16);
            }
            __syncthreads();
        }
        for (int it = gw; it < (NTOK / 32) * 4; it += NGW) {
            const int g = it & 3, tt = it >> 2, T0 = tt * 32, win = 2 << g;
            const int tok = T0 + r, tpos = tok & (SEQ - 1);
            const int cnt = (tpos + 1 < win) ? tpos + 1 : win;
            const float fc = (float)cnt;
            f32x16 acc[4];
#pragma unroll
            for (int dt = 0; dt < 4; ++dt)
#pragma unroll
                for (int ii = 0; ii < 16; ++ii) acc[dt][ii] = 0.f;
            const bf16* up = Z + (size_t)tok * DIN + ZU + g * 128 + 8 * hh;
            const bf16* wp = WPT + (size_t)g * 16384 + (size_t)r * 128 + 8 * hh;
            for (int kk = 0; kk < 8; ++kk) {
                float sm[8];
                const u32x4 u0 = *(const u32x4*)(up + 16 * kk);
                sm[0] = bflo(u0.x); sm[1] = bfhi(u0.x); sm[2] = bflo(u0.y); sm[3] = bfhi(u0.y); sm[4] = bflo(u0.z); sm[5] = bfhi(u0.z); sm[6] = bflo(u0.w); sm[7] = bfhi(u0.w);
                float own[8];
#pragma unroll
                for (int e = 0; e < 8; ++e) own[e] = sm[e];
                for (int w = 1; w < win; ++w) {
                    if (w < cnt) {
                        const u32x4 u = *(const u32x4*)(up + 16 * kk - (size_t)w * DIN);
                        sm[0] += bflo(u.x); sm[1] += bfhi(u.x); sm[2] += bflo(u.y); sm[3] += bfhi(u.y); sm[4] += bflo(u.z); sm[5] += bfhi(u.z); sm[6] += bflo(u.w); sm[7] += bfhi(u.w);
                    }
                }
                u32x4 pa;
                pa.x = cvtpk(sm[0] / fc - own[0], sm[1] / fc - own[1]); pa.y = cvtpk(sm[2] / fc - own[2], sm[3] / fc - own[3]);
                pa.z = cvtpk(sm[4] / fc - own[4], sm[5] / fc - own[5]); pa.w = cvtpk(sm[6] / fc - own[6], sm[7] / fc - own[7]);
                const bf16x8 a = __builtin_bit_cast(bf16x8, pa);
#pragma unroll
                for (int dt = 0; dt < 4; ++dt) { const bf16x8 bb = *(const bf16x8*)(wp + (size_t)dt * 32 * 128 + 16 * kk); acc[dt] = MFMA32(a, bb, acc[dt]); }
            }
#pragma unroll
            for (int dt = 0; dt < 4; ++dt) {
                const int col = g * 128 + 32 * dt + r; const float ps = p.pool_scale[col];
#pragma unroll
                for (int ii = 0; ii < 16; ++ii) {
                    const size_t t2 = (size_t)(T0 + crow(ii, hh));
                    const float gp = bflo((unsigned)Z[t2 * DIN + ZGP + col]);
                    Y[t2 * DM + 1024 + col] = (bf16)(cvtpk(acc[dt][ii] * ps * silu(gp), 0.f) & 0xffffu);
                }
            }
        }
    }
    xcd_barrier(bar);

    for (int ph = 4; ph <= 5; ++ph) {
        LAS unsigned* pre = (LAS unsigned*)(lds + PRE_OFF);
        int it0, it1;
        if (ph == 4) {
            const unsigned nch = (gcount[tid] + 255u) >> 8;
            unsigned v = nch;
#pragma unroll
            for (int off = 1; off < 64; off <<= 1) { const unsigned n = __shfl_up(v, off); if (lane >= off) v += n; }
            if (lane == 63) pre[516 + wave] = v;
            __syncthreads();
            unsigned wb = 0;
            for (int w = 0; w < wave; ++w) wb += pre[516 + w];
            pre[tid + 1] = wb + v; if (tid == 0) pre[0] = 0u;
            __syncthreads();
            const unsigned T = pre[512];
            it0 = (int)(((unsigned long long)T * (unsigned)bx) / (unsigned)G); it1 = (int)(((unsigned long long)T * (unsigned)(bx + 1)) / (unsigned)G);
        } else { it0 = 0; it1 = 0; for (int x = bx; x < 768; x += G) ++it1; }
        int cur = -1;
        for (int itn = it0; itn < it1; ++itn) {
            int kind, b, h, jblk = 0, chunk = 0, qt = 0; unsigned cnt = 0; int lid = 0;
            if (ph == 4) {
                int lo = 0, hi2 = 512;
                while (hi2 - lo > 1) { const int mid = (lo + hi2) >> 1; if (pre[mid] <= (unsigned)itn) lo = mid; else hi2 = mid; }
                lid = lo; chunk = itn - (int)pre[lid]; kind = 0; jblk = lid & 31; h = (lid >> 5) & 7; b = lid >> 8; cnt = gcount[lid];
            } else {
                const int idx = bx + (itn - it0) * G;
                if (idx < 512) { kind = 1; jblk = idx & 31; h = (idx >> 5) & 7; b = idx >> 8; lid = idx; }
                else { const int mi = idx - 512; kind = 2; b = mi >> 7; h = (mi >> 5) & 3; qt = mi & 31; lid = 1024 + (mi >> 5); }
            }
            const int key = (ph == 4) ? lid : (kind == 1 ? lid : lid);
            if (ph == 5 || key != cur) {
                __syncthreads();
                if (kind == 2) load_kv(lds, MK + (size_t)(b * MEML) * 512 + h * HD, 512, MVT + (size_t)((b * NHM + h) * 128) * 256, 256, tid);
                else load_kv(lds, Z + ((size_t)b * SEQ + (size_t)jblk * BLK) * DIN + ZK + h * HD, DIN, VT + (size_t)((b * NH + h) * 128) * SEQ + jblk * BLK, SEQ, tid);
                __syncthreads();
                cur = key;
            }
            bool active = true, valid = true; int s_q, slot = 0;
            if (kind == 0) {
                const unsigned base = (unsigned)chunk * 256u + (unsigned)wave * 32u;
                active = base < cnt;
                unsigned e_i = base + (unsigned)r; valid = e_i < cnt; if (!valid) e_i = cnt - 1u;
                const unsigned e = active ? LIST[(size_t)lid * 8192 + e_i] : 0u;
                s_q = (int)(e & 0xffffu); slot = (int)(e >> 16);
            } else if (kind == 1) s_q = jblk * BLK + wave * 32 + r;
            else s_q = qt * BLK + wave * 32 + r;
            if (!active) continue;
            const size_t tok = (size_t)b * SEQ + s_q;
            bf16x8 qf[8]; load_q(qf, Z + tok * DIN + (kind == 2 ? ZQM : ZQ) + h * HD, hh);
            f32x16 o[4]; float m, l;
            attn_core(lds, qf, kind == 1 ? wave + 1 : 8, kind == 1, wave * 32 + r, r, hh, o, m, l);
            l += __shfl_xor(l, 32);
            const float m2 = m * SM_C;
            if (kind == 0) {
                if (valid) {
                    const float inv = 1.0f / l;
                    bf16* op = OP + (((size_t)slot * NTOK + tok) * NH + h) * HD + 4 * hh;
#pragma unroll
                    for (int dt = 0; dt < 4; ++dt)
#pragma unroll
                        for (int g4 = 0; g4 < 4; ++g4) { u32x2 w; w.x = cvtpk(o[dt][4 * g4] * inv, o[dt][4 * g4 + 1] * inv); w.y = cvtpk(o[dt][4 * g4 + 2] * inv, o[dt][4 * g4 + 3] * inv);
                            *(u32x2*)(op + 32 * dt + 8 * g4) = w; }
                    if (hh == 0) { f32x2_t ml = {m2, l}; MLB[((size_t)slot * NTOK + tok) * NH + h] = ml; }
                }
            } else if (kind == 1) {
                const int nv = jblk < 3 ? jblk : 3;
                float mk[3], lk[3]; float M = m2;
#pragma unroll
                for (int k = 0; k < 3; ++k) { mk[k] = -1e30f; lk[k] = 0.f; if (k < nv) { const f32x2_t ml = MLB[((size_t)k * NTOK + tok) * NH + h]; mk[k] = ml.x; lk[k] = ml.y; M = fmaxf(M, ml.x); } }
                const float w0 = __builtin_amdgcn_exp2f(m2 - M); float L = l * w0; float wk[3];
#pragma unroll
                for (int k = 0; k < 3; ++k) { wk[k] = (k < nv) ? lk[k] * __builtin_amdgcn_exp2f(mk[k] - M) : 0.f; L += wk[k]; }
                const float inv = 1.0f / L;
                const bf16* gp = Z + tok * DIN + ZGA + h * HD + 4 * hh;
                bf16* yp = Y + tok * DM + h * HD + 4 * hh;
#pragma unroll
                for (int dt = 0; dt < 4; ++dt)
#pragma unroll
                    for (int g4 = 0; g4 < 4; ++g4) {
                        float a0 = o[dt][4 * g4] * w0, a1 = o[dt][4 * g4 + 1] * w0, a2 = o[dt][4 * g4 + 2] * w0, a3 = o[dt][4 * g4 + 3] * w0;
#pragma unroll
                        for (int k = 0; k < 3; ++k) if (k < nv) {
                            const u32x2 pv = *(const u32x2*)(OP + (((size_t)k * NTOK + tok) * NH + h) * HD + 4 * hh + 32 * dt + 8 * g4);
                            a0 += wk[k] * bflo(pv.x); a1 += wk[k] * bfhi(pv.x); a2 += wk[k] * bflo(pv.y); a3 += wk[k] * bfhi(pv.y);
                        }
                        const u32x2 gv = *(const u32x2*)(gp + 32 * dt + 8 * g4);
                        u32x2 w; w.x = cvtpk(a0 * inv * silu(bflo(gv.x)), a1 * inv * silu(bfhi(gv.x))); w.y = cvtpk(a2 * inv * silu(bflo(gv.y)), a3 * inv * silu(bfhi(gv.y)));
                        *(u32x2*)(yp + 32 * dt + 8 * g4) = w;
                    }
            } else {
                const float inv = 1.0f / l;
                const bf16* gp = Z + tok * DIN + ZGM + h * HD + 4 * hh;
                bf16* yp = Y + tok * DM + 1536 + h * HD + 4 * hh;
#pragma unroll
                for (int dt = 0; dt < 4; ++dt)
#pragma unroll
                    for (int g4 = 0; g4 < 4; ++g4) {
                        const u32x2 gv = *(const u32x2*)(gp + 32 * dt + 8 * g4);
                        u32x2 w; w.x = cvtpk(o[dt][4 * g4] * inv * silu(bflo(gv.x)), o[dt][4 * g4 + 1] * inv * silu(bfhi(gv.x)));
                        w.y = cvtpk(o[dt][4 * g4 + 2] * inv * silu(bflo(gv.y)), o[dt][4 * g4 + 3] * inv * silu(bfhi(gv.y)));
                        *(u32x2*)(yp + 32 * dt + 8 * g4) = w;
                    }
            }
        }
        __syncthreads();
        xcd_barrier(bar);
    }

    {
        pg8::Gemm g{Y, WOUTT, NTOK, DM, DM}; pg8::StaticOrder S; S.init(NTOK, DM, G, bx);
        EpiResF32 E{p.x, p.out, DM};
        pg8::gemm_phase<EpiResF32, pg8::StaticOrder, true, true>(lds, g, S, E);
    }
    xcd_barrier(bar);

    for (int m = gw; m < NTOK; m += NGW) rms_row_f32(p.out + (size_t)m * DM, p.final_g, lane);
}

extern "C" void kernel_launch(void* const* d_in, const int* in_sizes, int n_in, void* d_out, int out_size, void* d_ws, size_t ws_size, hipStream_t stream) {
    static int grid = 0;
    if (grid == 0) {
        if (n_in != 10 || in_sizes[0] != NTOK * DM || out_size != NTOK * DM || ws_size < WS_END) {
            fprintf(stderr, "kernel_launch: unexpected shapes (n_in %d, in0 %d, out %d, ws %zu)\n", n_in, n_in > 0 ? in_sizes[0] : -1, out_size, ws_size); grid = -1; return; }
        int dev = 0, cus = 0, per_cu = 0;
        hipGetDevice(&dev); hipDeviceGetAttribute(&cus, hipDeviceAttributeMultiprocessorCount, dev);
        if (hipFuncSetAttribute((const void*)hybrid_fwd, hipFuncAttributeMaxDynamicSharedMemorySize, LDS_BYTES) != hipSuccess) { fprintf(stderr, "kernel_launch: hipFuncSetAttribute failed\n"); grid = -1; return; }
        if (hipOccupancyMaxActiveBlocksPerMultiprocessor(&per_cu, (const void*)hybrid_fwd, 512, LDS_BYTES) != hipSuccess || per_cu < 1) { fprintf(stderr, "kernel_launch: occupancy query says %d\n", per_cu); per_cu = 1; }
        (void)hipGetLastError();
        grid = cus;
    }
    if (grid < 0) return;
    Params p{};
    p.x = (const float*)d_in[0]; p.mem = (const float*)d_in[1]; p.norm_g = (const float*)d_in[2]; p.mem_norm_g = (const float*)d_in[3];
    p.w_in = (const float*)d_in[4]; p.w_mem_kv = (const float*)d_in[5]; p.w_pool = (const float*)d_in[6]; p.pool_scale = (const float*)d_in[7];
    p.w_out = (const float*)d_in[8]; p.final_g = (const float*)d_in[9]; p.out = (float*)d_out; p.ws = (unsigned char*)d_ws;
    if (hipMemsetAsync((char*)d_ws + WS_BAR, 0, BAR_BYTES, stream) != hipSuccess) { fprintf(stderr, "memset failed\n"); return; }
    void* args[] = {&p};
    hipError_t e = hipLaunchCooperativeKernel((const void*)hybrid_fwd, dim3(grid), dim3(512), args, LDS_BYTES, stream);
    if (e != hipSuccess) fprintf(stderr, "cooperative launch failed: %s (grid %d)\n", hipGetErrorString(e), grid);
}
```

```cpp
#include <hip/hip_runtime.h>
#include <hip/hip_cooperative_groups.h>
#include <cstdio>
#include <cstdint>
namespace cg = cooperative_groups;
namespace pg8 {
#define PG8_LAS __attribute__((address_space(3)))
typedef unsigned short bf16_t;
typedef short bf16x8 __attribute__((ext_vector_type(8)));
typedef float f32x4 __attribute__((ext_vector_type(4)));
typedef unsigned u32x4 __attribute__((ext_vector_type(4)));
constexpr int BM = 256, BK = 64, HALF = 128, HTB = HALF * BK * 2  , STAGE_BYTES = 8 * HTB, NXCD = 8, WGM = 8;

__host__ __device__ __forceinline__ int lds_byte(int r, int c) { const int st = (r >> 4) * 2 + (c >> 5), rr = r & 15, cc = c & 31, ob = rr * 64 + cc * 2; return st * 1024 + (ob ^ (((ob >> 9) & 1) << 5)); }
__host__ __device__ __forceinline__ void stage_rc(int b, int& R, int& C) { const int st = b / 1024, sb = b % 1024, swz = sb ^ (((sb >> 9) & 1) << 5); R = (st >> 1) * 16 + swz / 64; C = (st & 1) * 32 + (swz % 64) / 2; }
__host__ __device__ __forceinline__ int perm32(int rho) { const int n = rho >> 4, i = rho & 15; return 8 * (i >> 2) + 4 * n + (i & 3); }

struct Unit { int pm, pn; };
struct Gemm { const bf16_t* A; const bf16_t* Bt; int M, N, K; };

struct StaticOrder {
    int nM, nN, nwg, G, c;
    __host__ __device__ void init(int M, int N, int G_, int c_) { nM = M / BM; nN = N / BM; nwg = nM * nN; G = G_; c = c_; }
    __host__ __device__ bool next(int i, Unit& u) const {
        const long L = (long)i * G + c; if (L >= nwg) return false;
        int wgid = (int)L; { const int q = nwg / NXCD, r = nwg % NXCD, xcd = wgid % NXCD, off = wgid / NXCD; wgid = (xcd < r ? xcd * (q + 1) : r * (q + 1) + (xcd - r) * q) + off; }
        const int nig = WGM * nN, gid = wgid / nig, fm = gid * WGM, gsz = (nM - fm) < WGM ? (nM - fm) : WGM;
        u.pm = fm + ((wgid % nig) % gsz); u.pn = (wgid % nig) / gsz; return true;
    }
    __device__ __forceinline__ void a_ready(const Unit&) const {}
    __device__ __forceinline__ void done(const Unit&) const {}
};

__device__ __forceinline__ unsigned cvt_pk_bf16(float lo, float hi) { unsigned r; asm volatile("v_cvt_pk_bf16_f32 %0, %1, %2" : "=v"(r) : "v"(lo), "v"(hi)); return r; }
typedef float f32x2 __attribute__((ext_vector_type(2)));
__device__ __forceinline__ f32x2 gelu_pk(f32x2 v) {
    const f32x2 av = __builtin_elementwise_abs(v), d = av * 0.2316418882f + 1.0f;
    f32x2 t; t.x = __builtin_amdgcn_rcpf(d.x); t.y = __builtin_amdgcn_rcpf(d.y);
    f32x2 q = t * 0.5307027145f + (-0.7265760135f); q = q * t + 0.7107068705f; q = q * t + (-0.142248368f); q = q * t + 0.127414796f; q = q * t;
    const f32x2 s = (v * v) * (-0.72134752044f);
    f32x2 e; e.x = __builtin_amdgcn_exp2f(s.x); e.y = __builtin_amdgcn_exp2f(s.y);
    const f32x2 m = v * (q * e), r = v - m;
    f32x2 o; o.x = v.x < 0.f ? m.x : r.x; o.y = v.y < 0.f ? m.y : r.y; return o;
}

template <int ACT  > struct EpiBf16 {
    static constexpr bool PERM = true, AFTER_DRAIN = false; static_assert(ACT == 0 || ACT == 1, "EpiBf16: ACT is 0 (none) or 1 (gelu_pk)");
    bf16_t* O; int ldc; const float* bias; int split_cols; size_t split_stride; float scale0;
    __device__ __forceinline__ void operator()(const f32x4 (&acc)[2][2][4][2], const Unit& u, int wr, int wc, int fr, int fq) const {
        const int row0 = u.pm * BM + wr * 64 + fr; int colt = u.pn * BM; bf16_t* base = O;
        float sc = 1.f; if (split_cols) { const int t = colt / split_cols; base += (size_t)t * split_stride; colt -= t * split_cols; if (t == 0) sc = scale0; }
        const int col0 = colt + wc * 32 + 8 * fq, bcol0 = u.pn * BM + wc * 32 + 8 * fq;
        f32x4 bv[2][2];
#pragma unroll
        for (int bj = 0; bj < 2; ++bj)
#pragma unroll
            for (int n = 0; n < 2; ++n) bv[bj][n] = bias ? *(const f32x4*)(bias + bcol0 + bj * HALF + 4 * n) : (f32x4){0.f, 0.f, 0.f, 0.f};
#pragma unroll
        for (int ai = 0; ai < 2; ++ai)
#pragma unroll
            for (int m = 0; m < 4; ++m) { bf16_t* rowp = base + (size_t)(row0 + ai * HALF + m * 16) * ldc + col0;
#pragma unroll
                for (int bj = 0; bj < 2; ++bj) { f32x4 v0 = acc[ai][bj][m][0] + bv[bj][0], v1 = acc[ai][bj][m][1] + bv[bj][1];
                    if (ACT == 1) { f32x2 a = gelu_pk((f32x2){v0[0], v0[1]}), b = gelu_pk((f32x2){v0[2], v0[3]}), c = gelu_pk((f32x2){v1[0], v1[1]}), d = gelu_pk((f32x2){v1[2], v1[3]});
                        v0 = (f32x4){a.x, a.y, b.x, b.y}; v1 = (f32x4){c.x, c.y, d.x, d.y}; }
                    v0 = v0 * sc; v1 = v1 * sc; u32x4 w; w.x = cvt_pk_bf16(v0[0], v0[1]); w.y = cvt_pk_bf16(v0[2], v0[3]); w.z = cvt_pk_bf16(v1[0], v1[1]); w.w = cvt_pk_bf16(v1[2], v1[3]);
                    *(u32x4*)(rowp + bj * HALF) = w; } }
    }
};
template <class Epi, class Sched, bool ALIGN_EPI = false, bool SP2 = false>
__device__ __forceinline__ void gemm_phase(PG8_LAS unsigned char* lds, const Gemm g, const Sched& S, const Epi& E) {
    int tid_ = threadIdx.x; asm volatile("" : "+v"(tid_));
    const int tid = tid_, wid = __builtin_amdgcn_readfirstlane(tid >> 6), lane = tid & 63, wr = wid >> 2, wc = wid & 3, fr = lane & 15, fq = lane >> 4;
    const int K = g.K, nt = K / BK;
    unsigned voffA[2], voffB[2];
#pragma unroll
    for (int i = 0; i < 2; ++i) { int R, C; stage_rc(tid * 16 + i * 8192, R, C); const int Rb = Epi::PERM ? ((R & ~31) + perm32(R & 31)) : R;
        voffA[i] = (unsigned)(R * K + C) * 2u; voffB[i] = (unsigned)(Rb * K + C) * 2u; }
    const size_t kstep = (size_t)(BK * 2);
    const size_t hstep = (size_t)HALF * K * 2;
    const size_t tstep = 2 * hstep;
    const unsigned ldsw = (unsigned)wid * 1024u;
    const int aoff = lds_byte(wr * 64 + fr, fq * 8), boff = lds_byte(wc * 32 + fr, fq * 8);
#define PG8_SA(b, h) (((b) * 2 + (h)) * HTB)
#define PG8_SB(b, h) ((4 + (b) * 2 + (h)) * HTB)
#define PG8_STAGE(bufoff, gbase, voff) do { _Pragma("unroll") for (int _i = 0; _i < 2; ++_i) \
        __builtin_amdgcn_global_load_lds((const unsigned*)((const char*)(gbase) + (voff)[_i]), (PG8_LAS unsigned*)(lds + (bufoff) + ldsw + _i * 8192), 16, 0, 0); } while (0)
#define PG8_LDA(dst, b, h) do { _Pragma("unroll") for (int m = 0; m < 4; ++m) _Pragma("unroll") for (int k = 0; k < 2; ++k) dst[m][k] = *(const PG8_LAS bf16x8*)(lds + PG8_SA(b, h) + aoff + m * 2048 + k * 1024); } while (0)
#define PG8_LDB(dst, b, h) do { _Pragma("unroll") for (int n = 0; n < 2; ++n) _Pragma("unroll") for (int k = 0; k < 2; ++k) dst[n][k] = *(const PG8_LAS bf16x8*)(lds + PG8_SB(b, h) + boff + n * 2048 + k * 1024); } while (0)
#define PG8_MMA(ai, bj, At, Bt) do { __builtin_amdgcn_s_setprio(1); _Pragma("unroll") for (int m = 0; m < 4; ++m) _Pragma("unroll") for (int n = 0; n < 2; ++n) _Pragma("unroll") for (int k = 0; k < 2; ++k) \
        acc[ai][bj][m][n] = __builtin_amdgcn_mfma_f32_16x16x32_bf16(Bt[n][k], At[m][k], acc[ai][bj][m][n], 0, 0, 0); __builtin_amdgcn_s_setprio(0); } while (0)
#define PG8_WAIT_V(n) asm volatile("s_waitcnt vmcnt(" #n ")" ::: "memory")
#define PG8_WAIT_L(n) asm volatile("s_waitcnt lgkmcnt(" #n ")" ::: "memory")
#define PG8_BAR __builtin_amdgcn_s_barrier()
#define PG8_SCHED __builtin_amdgcn_sched_barrier(0)
    Unit cur, nxt; int ui = 0;
    if (!S.next(0, cur)) return;
    f32x4 acc[2][2][4][2];
#pragma unroll
    for (int a = 0; a < 2; ++a)
#pragma unroll
        for (int b = 0; b < 2; ++b)
#pragma unroll
            for (int m = 0; m < 4; ++m)
#pragma unroll
                for (int n = 0; n < 2; ++n) acc[a][b][m][n] = (f32x4){0.f, 0.f, 0.f, 0.f};
    bf16x8 At[4][2], B0[2][2], B1[2][2];
    const char* cA = (const char*)g.A + (size_t)cur.pm * tstep; const char* cB = (const char*)g.Bt + (size_t)cur.pn * tstep;
    S.a_ready(cur);
    if constexpr (SP2) {
        PG8_STAGE(PG8_SB(0, 0), cB, voffB); PG8_STAGE(PG8_SB(0, 1), cB + hstep, voffB); PG8_STAGE(PG8_SA(0, 0), cA, voffA); PG8_STAGE(PG8_SA(0, 1), cA + hstep, voffA);
        if (wr == 1) PG8_BAR;
        PG8_WAIT_V(2); PG8_BAR;
        PG8_STAGE(PG8_SB(1, 0), cB + kstep, voffB); PG8_STAGE(PG8_SA(1, 0), cA + kstep, voffA); PG8_STAGE(PG8_SB(1, 1), cB + hstep + kstep, voffB);
        PG8_WAIT_V(6); PG8_BAR;
    } else {
        PG8_STAGE(PG8_SB(0, 0), cB, voffB); PG8_STAGE(PG8_SA(0, 0), cA, voffA); PG8_STAGE(PG8_SB(0, 1), cB + hstep, voffB); PG8_STAGE(PG8_SA(0, 1), cA + hstep, voffA);
        if (wr == 1) PG8_BAR;
        PG8_WAIT_V(4); PG8_BAR;
        PG8_STAGE(PG8_SB(1, 0), cB + kstep, voffB); PG8_STAGE(PG8_SA(1, 0), cA + kstep, voffA); PG8_STAGE(PG8_SB(1, 1), cB + hstep + kstep, voffB);
        PG8_WAIT_V(6); PG8_BAR;
    }
    for (;;) {
        const bool has_next = S.next(ui + 1, nxt);
        const char* nA = has_next ? (const char*)g.A + (size_t)nxt.pm * tstep : cA; const char* nB = has_next ? (const char*)g.Bt + (size_t)nxt.pn * tstep : cB;
        for (int t = 0; t < nt; t += 2) {
            const bool last = (t == nt - 2);
            const char* a1 = cA + (size_t)(t + 1) * kstep;
            const char* a2 = last ? nA : cA + (size_t)(t + 2) * kstep; const char* b2 = last ? nB : cB + (size_t)(t + 2) * kstep;
            const char* a3 = a2 + kstep; const char* b3 = b2 + kstep;
            if (last && has_next) S.a_ready(nxt);
            if constexpr (SP2) {
            PG8_LDB(B0, 0, 0); PG8_LDB(B1, 0, 1); PG8_SCHED; PG8_LDA(At, 0, 0); PG8_STAGE(PG8_SA(1, 1), a1 + hstep, voffA);
            PG8_WAIT_V(8); PG8_WAIT_L(0); PG8_BAR; PG8_MMA(0, 0, At, B0); PG8_MMA(0, 1, At, B1); PG8_BAR; PG8_SCHED;
            PG8_LDA(At, 0, 1); PG8_STAGE(PG8_SB(0, 0), b2, voffB); PG8_STAGE(PG8_SB(0, 1), b2 + hstep, voffB); PG8_STAGE(PG8_SA(0, 0), a2, voffA);
            PG8_WAIT_V(8); PG8_WAIT_L(0); PG8_BAR; PG8_MMA(1, 0, At, B0); PG8_MMA(1, 1, At, B1); PG8_BAR; PG8_SCHED;
            PG8_LDB(B0, 1, 0); PG8_LDB(B1, 1, 1); PG8_SCHED; PG8_LDA(At, 1, 0); PG8_STAGE(PG8_SA(0, 1), a2 + hstep, voffA);
            PG8_WAIT_V(8); PG8_WAIT_L(0); PG8_BAR; PG8_MMA(0, 0, At, B0); PG8_MMA(0, 1, At, B1); PG8_BAR; PG8_SCHED;
            PG8_LDA(At, 1, 1); PG8_STAGE(PG8_SB(1, 0), b3, voffB); PG8_STAGE(PG8_SB(1, 1), b3 + hstep, voffB); PG8_STAGE(PG8_SA(1, 0), a3, voffA);
            PG8_WAIT_V(8); PG8_WAIT_L(0); PG8_BAR; PG8_MMA(1, 0, At, B0); PG8_MMA(1, 1, At, B1); PG8_BAR; PG8_SCHED;
            } else {
            PG8_LDB(B0, 0, 0); PG8_SCHED; PG8_LDA(At, 0, 0); PG8_STAGE(PG8_SA(1, 1), a1 + hstep, voffA);
            PG8_WAIT_L(8); PG8_BAR; PG8_WAIT_L(0); PG8_MMA(0, 0, At, B0); PG8_BAR; PG8_SCHED;
            PG8_LDB(B1, 0, 1); PG8_STAGE(PG8_SB(0, 0), b2, voffB);
            PG8_BAR; PG8_WAIT_L(0); PG8_MMA(0, 1, At, B1); PG8_BAR;
            PG8_LDA(At, 0, 1); PG8_STAGE(PG8_SA(0, 0), a2, voffA);
            PG8_BAR; PG8_WAIT_L(0); PG8_MMA(1, 0, At, B0); PG8_BAR; PG8_SCHED;
            PG8_STAGE(PG8_SB(0, 1), b2 + hstep, voffB);
            PG8_WAIT_V(6); PG8_BAR; PG8_MMA(1, 1, At, B1); PG8_BAR;
            PG8_LDB(B0, 1, 0); PG8_SCHED; PG8_LDA(At, 1, 0); PG8_STAGE(PG8_SA(0, 1), a2 + hstep, voffA);
            PG8_WAIT_L(8); PG8_BAR; PG8_WAIT_L(0); PG8_MMA(0, 0, At, B0); PG8_BAR; PG8_SCHED;
            PG8_LDB(B1, 1, 1); PG8_STAGE(PG8_SB(1, 0), b3, voffB);
            PG8_BAR; PG8_WAIT_L(0); PG8_MMA(0, 1, At, B1); PG8_BAR;
            PG8_LDA(At, 1, 1); PG8_STAGE(PG8_SA(1, 0), a3, voffA);
            PG8_BAR; PG8_WAIT_L(0); PG8_MMA(1, 0, At, B0); PG8_BAR; PG8_SCHED;
            PG8_STAGE(PG8_SB(1, 1), b3 + hstep, voffB);
            PG8_WAIT_V(6); PG8_BAR; PG8_MMA(1, 1, At, B1); PG8_BAR;
            }
        }
        if constexpr (ALIGN_EPI) { if (wr == 0) PG8_BAR; }
        if constexpr (!Epi::AFTER_DRAIN) { E(acc, cur, wr, wc, fr, fq); S.done(cur); }
        if (!has_next) break;
#pragma unroll
        for (int a = 0; a < 2; ++a)
#pragma unroll
            for (int b = 0; b < 2; ++b)
#pragma unroll
                for (int m = 0; m < 4; ++m)
#pragma unroll
                    for (int n = 0; n < 2; ++n) acc[a][b][m][n] = (f32x4){0.f, 0.f, 0.f, 0.f};
        cur = nxt; cA = nA; cB = nB; ++ui;
        if constexpr (ALIGN_EPI) { if (wr == 1) PG8_BAR; }
    }
    PG8_WAIT_V(0);
    if constexpr (!ALIGN_EPI) { if (wr == 0) PG8_BAR; }
    PG8_BAR;
    if constexpr (Epi::AFTER_DRAIN) { E.fused(acc, cur, wr, wc, fr, fq, lds, wid, lane); S.done(cur); }
#undef PG8_SA
#undef PG8_SB
#undef PG8_STAGE
#undef PG8_LDA
#undef PG8_LDB
#undef PG8_MMA
#undef PG8_WAIT_V
#undef PG8_WAIT_L
#undef PG8_BAR
#undef PG8_SCHED
}
}
constexpr int BATCH = 2, SEQ = 8192, DM = 2048, NTOK = BATCH * SEQ, DIN = 6144, MEML = 256;
constexpr int NH = 8, HD = 128, NHM = 4, NBLK = 32, BLK = 256;
constexpr int ZQ = 0, ZK = 1024, ZV = 2048, ZGA = 3072, ZU = 4096, ZGP = 4608, ZQM = 5120, ZGM = 5632;
constexpr float EPS = 1e-6f;
constexpr float SM_C = 0.08838834764831845f * 1.4426950408889634f;

constexpr size_t MiB = 1u << 20;
constexpr size_t WS_CNT = 0; constexpr size_t WS_BAR = 524288, BAR_BYTES = 16384;
constexpr int MISC_OFF = 147456 - 64;
constexpr size_t WS_KMH = 1 * MiB, WS_KML = WS_KMH + 131072, WS_WPT = WS_KML + 131072;
constexpr size_t WS_MK = 2 * MiB;
constexpr size_t WS_MVT = 3 * MiB;
constexpr size_t WS_MEMH = 4 * MiB;
constexpr size_t WS_WMEMT = 6 * MiB;
constexpr size_t WS_WOUTT = 10 * MiB;
constexpr size_t WS_WINT = 18 * MiB;
constexpr size_t WS_LIST = 42 * MiB;
constexpr size_t WS_ML = 58 * MiB;
constexpr size_t WS_H = 64 * MiB;
constexpr size_t WS_Y = WS_H;
constexpr size_t WS_Z = 128 * MiB;
constexpr size_t WS_VT = 320 * MiB;
constexpr size_t WS_OP = 352 * MiB;
constexpr size_t WS_END = 480 * MiB;

constexpr int LDS_BYTES = 147456;
constexpr int KL_OFF = 0, KL_STRIDE = 272, VL_OFF = 256 * KL_STRIDE, VL_STRIDE = 528, PRE_OFF = VL_OFF + 128 * VL_STRIDE;
static_assert(PRE_OFF + 532 * 4 <= 147456 - 64, "lds map");

#define LAS __attribute__((address_space(3)))
typedef unsigned short bf16;
typedef short bf16x8 __attribute__((ext_vector_type(8)));
typedef float f32x4 __attribute__((ext_vector_type(4)));
typedef float f32x16 __attribute__((ext_vector_type(16)));
typedef unsigned u32x4 __attribute__((ext_vector_type(4)));
typedef unsigned u32x2 __attribute__((ext_vector_type(2)));
typedef float f32x2_t __attribute__((ext_vector_type(2)));
typedef __bf16 bf16x2_t __attribute__((ext_vector_type(2)));
#define DI __device__ __forceinline__
DI unsigned cvtpk(float lo, float hi) { f32x2_t v = {lo, hi}; bf16x2_t b = __builtin_convertvector(v, bf16x2_t); return __builtin_bit_cast(unsigned, b); }
DI float bflo(unsigned u) { return __uint_as_float(u << 16); }
DI float bfhi(unsigned u) { return __uint_as_float(u & 0xffff0000u); }
DI float wave_sum(float v) {
#pragma unroll
    for (int o = 1; o < 64; o <<= 1) v += __shfl_xor(v, o);
    return v;
}
DI int crow(int i, int h) { return (i & 3) + 8 * (i >> 2) + 4 * h; }
DI int pi32(int r) { return (r & ~12) | ((r & 4) << 1) | ((r & 8) >> 1); }
DI float silu(float g) { return g / (1.0f + __expf(-g)); }
#define MFMA32(a, b, c) __builtin_amdgcn_mfma_f32_32x32x16_bf16((a), (b), (c), 0, 0, 0)

struct Params {
    const float *x, *mem, *norm_g, *mem_norm_g, *w_in, *w_mem_kv, *w_pool, *pool_scale, *w_out, *final_g;
    float* out; unsigned char* ws;
};

struct EpiResF32 {
    static constexpr bool PERM = false, AFTER_DRAIN = false;
    const float* base; float* out; int ldc;
    __device__ __forceinline__ void operator()(const pg8::f32x4 (&acc)[2][2][4][2], const pg8::Unit& u, int wr, int wc, int fr, int fq) const {
        const int col0 = u.pn * pg8::BM + wc * 32 + 4 * fq;
#pragma unroll
        for (int ai = 0; ai < 2; ++ai)
#pragma unroll
            for (int m = 0; m < 4; ++m) {
                const size_t off = (size_t)(u.pm * pg8::BM + ai * pg8::HALF + wr * 64 + m * 16 + fr) * ldc + col0;
#pragma unroll
                for (int bj = 0; bj < 2; ++bj)
#pragma unroll
                    for (int n = 0; n < 2; ++n) {
                        const pg8::f32x4 b = *(const pg8::f32x4*)(base + off + bj * pg8::HALF + n * 16);
                        *(pg8::f32x4*)(out + off + bj * pg8::HALF + n * 16) = acc[ai][bj][m][n] + b;
                    }
            }
    }
};
struct EpiZ {
    static constexpr bool PERM = true, AFTER_DRAIN = false;
    bf16* O; int ldc;
    __device__ __forceinline__ void operator()(const pg8::f32x4 (&acc)[2][2][4][2], const pg8::Unit& u, int wr, int wc, int fr, int fq) const {
        const int row0 = u.pm * pg8::BM + wr * 64 + fr; const int col0 = u.pn * pg8::BM + wc * 32 + 8 * fq;
#pragma unroll
        for (int ai = 0; ai < 2; ++ai)
#pragma unroll
            for (int m = 0; m < 4; ++m) { bf16* rowp = O + (size_t)(row0 + ai * pg8::HALF + m * 16) * ldc + col0;
#pragma unroll
                for (int bj = 0; bj < 2; ++bj) { const pg8::f32x4 v0 = acc[ai][bj][m][0], v1 = acc[ai][bj][m][1];
                    u32x4 w; w.x = cvtpk(v0[0], v0[1]); w.y = cvtpk(v0[2], v0[3]); w.z = cvtpk(v1[0], v1[1]); w.w = cvtpk(v1[2], v1[3]);
                    *(u32x4*)(rowp + bj * pg8::HALF) = w; } }
    }
};

DI void transpose_item(const float* W, int K, int N, bf16* WT, LAS float* scr, int item, int lane) {
    const int nblk = N / 32, kb = item / nblk, nb = item % nblk, k0 = 64 * kb, n0 = 32 * nb;
#pragma unroll 8
    for (int i = 0; i < 32; ++i) { const int kk = 2 * i + (lane >> 5); scr[kk * 33 + (lane & 31)] = W[(size_t)(k0 + kk) * N + n0 + (lane & 31)]; }
    __builtin_amdgcn_fence(__ATOMIC_RELEASE, "wavefront"); asm volatile("s_waitcnt lgkmcnt(0)" ::: "memory");
    const int c = lane & 7;
#pragma unroll
    for (int j = 0; j < 4; ++j) { const int n = (lane >> 3) + 8 * j; const LAS float* s = scr + (8 * c) * 33 + n;
        u32x4 o; o.x = cvtpk(s[0 * 33], s[1 * 33]); o.y = cvtpk(s[2 * 33], s[3 * 33]); o.z = cvtpk(s[4 * 33], s[5 * 33]); o.w = cvtpk(s[6 * 33], s[7 * 33]);
        *(u32x4*)(WT + (size_t)(n0 + n) * K + k0 + 8 * c) = o; }
    asm volatile("s_waitcnt lgkmcnt(0)" ::: "memory");
}
DI void rms_row_bf16(const float* xrow, const float* g, bf16* orow, int lane) {
    const f32x4* xr = (const f32x4*)xrow + lane; const f32x4* gr = (const f32x4*)g + lane;
    f32x4 v[8]; float s = 0.f;
#pragma unroll
    for (int j = 0; j < 8; ++j) { v[j] = xr[64 * j]; s += (v[j].x * v[j].x + v[j].y * v[j].y) + (v[j].z * v[j].z + v[j].w * v[j].w); }
    const float rstd = 1.0f / sqrtf(wave_sum(s) * (1.f / DM) + EPS);
    u32x2* o8 = (u32x2*)orow + lane;
#pragma unroll
    for (int j = 0; j < 8; ++j) { const f32x4 gg = gr[64 * j]; u32x2 w; w.x = cvtpk(v[j].x * rstd * gg.x, v[j].y * rstd * gg.y); w.y = cvtpk(v[j].z * rstd * gg.z, v[j].w * rstd * gg.w); o8[64 * j] = w; }
}
DI void rms_row_f32(float* row, const float* g, int lane) {
    f32x4* xr = (f32x4*)row + lane; const f32x4* gr = (const f32x4*)g + lane;
    f32x4 v[8]; float s = 0.f;
#pragma unroll
    for (int j = 0; j < 8; ++j) { v[j] = xr[64 * j]; s += (v[j].x * v[j].x + v[j].y * v[j].y) + (v[j].z * v[j].z + v[j].w * v[j].w); }
    const float rstd = 1.0f / sqrtf(wave_sum(s) * (1.f / DM) + EPS);
#pragma unroll
    for (int j = 0; j < 8; ++j) { const f32x4 gg = gr[64 * j]; xr[64 * j] = v[j] * rstd * gg; }
}

DI void attn_core(const LAS unsigned char* lds, const bf16x8 (&qf)[8], int ntiles, bool causal, int qlocal, int r, int hh, f32x16 (&o)[4], float& m, float& l) {
    m = -1e30f; l = 0.f;
#pragma unroll
    for (int dt = 0; dt < 4; ++dt)
#pragma unroll
        for (int i = 0; i < 16; ++i) o[dt][i] = 0.f;
    const LAS unsigned char* kbase = lds + KL_OFF + pi32(r) * KL_STRIDE + 16 * hh;
    const LAS unsigned char* vbase = lds + VL_OFF + r * VL_STRIDE + 16 * hh;
    for (int kt = 0; kt < ntiles; ++kt) {
        f32x16 s;
#pragma unroll
        for (int i = 0; i < 16; ++i) s[i] = 0.f;
        const LAS unsigned char* kp = kbase + kt * 32 * KL_STRIDE;
#pragma unroll
        for (int d0 = 0; d0 < 8; ++d0) { const bf16x8 kf = *(const LAS bf16x8*)(kp + 32 * d0); s = MFMA32(kf, qf[d0], s); }
        if (causal) {
#pragma unroll
            for (int i = 0; i < 16; ++i) { const int kl = 32 * kt + 16 * (i >> 3) + 8 * hh + (i & 7); if (kl > qlocal) s[i] = -INFINITY; }
        }
        float mx = s[0];
#pragma unroll
        for (int i = 1; i < 16; ++i) mx = fmaxf(mx, s[i]);
        mx = fmaxf(mx, __shfl_xor(mx, 32));
        const float mn = fmaxf(m, mx);
        const float alpha = __builtin_amdgcn_exp2f((m - mn) * SM_C);
        const float mnc = mn * SM_C;
        float ps = 0.f;
#pragma unroll
        for (int i = 0; i < 16; ++i) { s[i] = __builtin_amdgcn_exp2f(s[i] * SM_C - mnc); ps += s[i]; }
        l = l * alpha + ps; m = mn;
#pragma unroll
        for (int dt = 0; dt < 4; ++dt)
#pragma unroll
            for (int i = 0; i < 16; ++i) o[dt][i] *= alpha;
        u32x4 p0, p1;
        p0.x = cvtpk(s[0], s[1]); p0.y = cvtpk(s[2], s[3]); p0.z = cvtpk(s[4], s[5]); p0.w = cvtpk(s[6], s[7]);
        p1.x = cvtpk(s[8], s[9]); p1.y = cvtpk(s[10], s[11]); p1.z = cvtpk(s[12], s[13]); p1.w = cvtpk(s[14], s[15]);
        const bf16x8 pb0 = __builtin_bit_cast(bf16x8, p0), pb1 = __builtin_bit_cast(bf16x8, p1);
        const LAS unsigned char* vp = vbase + kt * 64;
#pragma unroll
        for (int dt = 0; dt < 4; ++dt) {
            const bf16x8 v0 = *(const LAS bf16x8*)(vp + dt * 32 * VL_STRIDE);
            const bf16x8 v1 = *(const LAS bf16x8*)(vp + dt * 32 * VL_STRIDE + 32);
            o[dt] = MFMA32(v0, pb0, o[dt]);
            o[dt] = MFMA32(v1, pb1, o[dt]);
        }
    }
}
DI void attn_core2(const LAS unsigned char* lds, const bf16x8 (&qf)[8], bool causal, int qlocal, int r, int hh, f32x16 (&o)[4], float& m2, float& l) {
    const LAS unsigned char* kbase = lds + KL_OFF + pi32(r) * KL_STRIDE + 16 * hh;
    const LAS unsigned char* vbase = lds + VL_OFF + r * VL_STRIDE + 16 * hh;
    f32x16 s[8];
#pragma unroll
    for (int kt = 0; kt < 8; ++kt) {
        f32x16 a;
#pragma unroll
        for (int i = 0; i < 16; ++i) a[i] = 0.f;
        const LAS unsigned char* kp = kbase + kt * 32 * KL_STRIDE;
#pragma unroll
        for (int d0 = 0; d0 < 8; ++d0) { const bf16x8 kf = *(const LAS bf16x8*)(kp + 32 * d0); a = MFMA32(kf, qf[d0], a); }
        s[kt] = a;
    }
    if (causal) {
        const int qh = qlocal - 8 * hh;
#pragma unroll
        for (int kt = 0; kt < 8; ++kt)
#pragma unroll
            for (int i = 0; i < 16; ++i) { if (32 * kt + 16 * (i >> 3) + (i & 7) > qh) s[kt][i] = -INFINITY; }
    }
    float mx = s[0][0];
#pragma unroll
    for (int kt = 0; kt < 8; ++kt)
#pragma unroll
        for (int i = 0; i < 16; ++i) mx = fmaxf(mx, s[kt][i]);
    mx = fmaxf(mx, __shfl_xor(mx, 32));
    const float mc = mx * SM_C;
    float ls = 0.f;
    u32x4 pb[8][2];
#pragma unroll
    for (int kt = 0; kt < 8; ++kt) {
        float e[16];
#pragma unroll
        for (int i = 0; i < 16; ++i) { e[i] = __builtin_amdgcn_exp2f(s[kt][i] * SM_C - mc); ls += e[i]; }
        pb[kt][0].x = cvtpk(e[0], e[1]); pb[kt][0].y = cvtpk(e[2], e[3]); pb[kt][0].z = cvtpk(e[4], e[5]); pb[kt][0].w = cvtpk(e[6], e[7]);
        pb[kt][1].x = cvtpk(e[8], e[9]); pb[kt][1].y = cvtpk(e[10], e[11]); pb[kt][1].z = cvtpk(e[12], e[13]); pb[kt][1].w = cvtpk(e[14], e[15]);
    }
#pragma unroll
    for (int dt = 0; dt < 4; ++dt)
#pragma unroll
        for (int i = 0; i < 16; ++i) o[dt][i] = 0.f;
#pragma unroll
    for (int kt = 0; kt < 8; ++kt) {
        const LAS unsigned char* vp = vbase + kt * 64;
#pragma unroll
        for (int dt = 0; dt < 4; ++dt) {
            const bf16x8 v0 = *(const LAS bf16x8*)(vp + dt * 32 * VL_STRIDE);
            const bf16x8 v1 = *(const LAS bf16x8*)(vp + dt * 32 * VL_STRIDE + 32);
            o[dt] = MFMA32(v0, __builtin_bit_cast(bf16x8, pb[kt][0]), o[dt]);
            o[dt] = MFMA32(v1, __builtin_bit_cast(bf16x8, pb[kt][1]), o[dt]);
        }
    }
    l = ls + __shfl_xor(ls, 32);
    m2 = mc;
}
DI void store_row_bf16(bf16* rowp, const f32x16 (&o)[4], float sc, int hh, bool pred) {
#pragma unroll
    for (int dt = 0; dt < 4; ++dt)
#pragma unroll
        for (int a = 0; a < 2; ++a) {
            const unsigned xa = cvtpk(o[dt][8 * a] * sc, o[dt][8 * a + 1] * sc), xb = cvtpk(o[dt][8 * a + 2] * sc, o[dt][8 * a + 3] * sc);
            const unsigned ya = cvtpk(o[dt][8 * a + 4] * sc, o[dt][8 * a + 5] * sc), yb = cvtpk(o[dt][8 * a + 6] * sc, o[dt][8 * a + 7] * sc);
            const auto r1 = __builtin_amdgcn_permlane32_swap(xa, ya, false, false);
            const auto r2 = __builtin_amdgcn_permlane32_swap(xb, yb, false, false);
            u32x4 w; w.x = r1[0]; w.y = r2[0]; w.z = r1[1]; w.w = r2[1];
            if (pred) *(u32x4*)(rowp + 32 * dt + 16 * a + 8 * hh) = w;
        }
}
DI void load_kv(LAS unsigned char* lds, const bf16* Kg, size_t kstride, const bf16* Vg, size_t vstride, int tid_in) {
    int tid = tid_in; asm volatile("" : "+v"(tid));
#pragma unroll
    for (int it = 0; it < 8; ++it) { const int id = tid + 512 * it, row = id >> 4, ch = id & 15;
        const u32x4 v = *(const u32x4*)(Kg + (size_t)row * kstride + ch * 8); *(LAS u32x4*)(lds + KL_OFF + row * KL_STRIDE + ch * 16) = v; }
#pragma unroll
    for (int it = 0; it < 8; ++it) { const int id = tid + 512 * it, d = id >> 5, ch = id & 31;
        const u32x4 v = *(const u32x4*)(Vg + (size_t)d * vstride + ch * 8); *(LAS u32x4*)(lds + VL_OFF + d * VL_STRIDE + ch * 16) = v; }
}
DI void load_q(bf16x8 (&qf)[8], const bf16* qrow, int hh) {
#pragma unroll
    for (int d0 = 0; d0 < 8; ++d0) qf[d0] = *(const bf16x8*)(qrow + 16 * d0 + 8 * hh);
}

typedef __attribute__((address_space(1))) unsigned gu32;
#define XB_TMO      128
#define XB_XCNT(j)  (256  + 64 * (j))
#define XB_XSUB(j)  (1280 + 64 * (j))
#define XB_XGEN(j)  (2304 + 64 * (j))
#define XB_TOP      3328
#define XB_TOPGEN   3392
#define XCD_BAR_WORDS 3456
#define XB_SPIN_CAP (1u << 18)

__device__ __forceinline__ unsigned xb_ld(unsigned* p)              { return __hip_atomic_load(p, __ATOMIC_RELAXED, __HIP_MEMORY_SCOPE_AGENT); }
__device__ __forceinline__ unsigned xb_add(unsigned* p, unsigned v) { return __hip_atomic_fetch_add(p, v, __ATOMIC_RELAXED, __HIP_MEMORY_SCOPE_AGENT); }
__device__ __forceinline__ unsigned xb_xcc_id() { return (unsigned)__builtin_amdgcn_s_getreg((3 << 11) | 20) & 0xFu; }
#define XB_SPIN(cond, bar) do { unsigned _sp = 0; while (cond) { __builtin_amdgcn_s_sleep(1); \
    if ((++_sp & 255u) == 0u) { if (xb_ld(&(bar)[XB_TMO])) break; if (_sp > XB_SPIN_CAP) { atomicAdd(&(bar)[XB_TMO], 1u); break; } } } } while (0)

struct XcdBarrier {
    unsigned* bar; unsigned x;
    volatile LAS unsigned* st;
};

__device__ __forceinline__ XcdBarrier xcd_barrier_post(unsigned* bar, volatile LAS unsigned* st) {
    XcdBarrier b; b.bar = bar; b.x = xb_xcc_id(); b.st = st;
    if (threadIdx.x == 0) (void)xb_add(&bar[XB_XCNT(b.x)], 1u);
    return b;
}
__device__ __forceinline__ void xcd_barrier_complete(unsigned* bar, unsigned x, unsigned& nloc, unsigned& nx) {
    const unsigned G = gridDim.x * gridDim.y * gridDim.z;
    unsigned sum, cnt, mine, sp = 0u;
    for (;;) {
        sum = 0u; cnt = 0u; mine = 0u;
#pragma unroll
        for (unsigned j = 0; j < 16; ++j) { const unsigned c = xb_ld(&bar[XB_XCNT(j)]); sum += c; cnt += (c > 0u) ? 1u : 0u; mine = (j == x) ? c : mine; }
        if (sum == G) break;
        __builtin_amdgcn_s_sleep(1);
        if ((++sp & 255u) == 0u) { if (xb_ld(&bar[XB_TMO])) break; if (sp > XB_SPIN_CAP) { atomicAdd(&bar[XB_TMO], 1u); break; } }
    }
    nloc = mine > 0u ? mine : 1u; nx = cnt > 0u ? cnt : 1u;
}

__device__ __forceinline__ void xcd_barrier(const XcdBarrier& b) {
    asm volatile("s_waitcnt vmcnt(0)" ::: "memory");
    __syncthreads();
    if (threadIdx.x == 0) {
        unsigned* bar = b.bar;
        __builtin_amdgcn_s_waitcnt(0);
        unsigned nloc = b.st[0], nx = b.st[1];
        if (nloc == 0u) { xcd_barrier_complete(bar, b.x, nloc, nx); b.st[0] = nloc; b.st[1] = nx; }
        const unsigned old = xb_add(&bar[XB_XSUB(b.x)], 1u);
        const unsigned gen = old / nloc;
        if (old + 1u == (gen + 1u) * nloc) {
            __builtin_amdgcn_fence(__ATOMIC_RELEASE, "agent");
            asm volatile("s_waitcnt vmcnt(0)" ::: "memory");
            const unsigned og = xb_add(&bar[XB_TOP], 1u);
            const unsigned tg = og / nx;
            if (og + 1u == (tg + 1u) * nx) xb_add(&bar[XB_TOPGEN], 1u);
            else XB_SPIN(xb_ld(&bar[XB_TOPGEN]) == tg, bar);
            __builtin_amdgcn_fence(__ATOMIC_ACQUIRE, "agent");
            xb_add(&bar[XB_XGEN(b.x)], 1u);
            asm volatile("s_waitcnt vmcnt(0)" ::: "memory");
        } else {
            XB_SPIN(xb_ld(&bar[XB_XGEN(b.x)]) == gen, bar);
            __builtin_amdgcn_fence(__ATOMIC_ACQUIRE, "agent");
            asm volatile("s_waitcnt vmcnt(0)" ::: "memory");
        }
    }
    __syncthreads();
}

__global__ void __launch_bounds__(512, 2) hybrid_fwd(Params p) {
    extern __shared__ __attribute__((aligned(16))) unsigned char lds_raw[];
    LAS unsigned char* lds = (LAS unsigned char*)lds_raw;
    cg::grid_group grid = cg::this_grid();
    const int tid = threadIdx.x, lane = tid & 63, wave = __builtin_amdgcn_readfirstlane(tid >> 6);
    const int G = gridDim.x, bx = blockIdx.x;
    const int gw = bx * 8 + wave, NGW = G * 8;
    const int r = lane & 31, hh = lane >> 5;
    unsigned char* ws = p.ws;
    if (tid < 16) ((LAS unsigned*)(lds + MISC_OFF))[tid] = 0u;
    __syncthreads();
    XcdBarrier bar = xcd_barrier_post((unsigned*)(ws + WS_BAR), (volatile LAS unsigned*)(lds + MISC_OFF));
    unsigned* gcount = (unsigned*)(ws + WS_CNT);
    bf16* KMH = (bf16*)(ws + WS_KMH); bf16* KML = (bf16*)(ws + WS_KML); bf16* WPT = (bf16*)(ws + WS_WPT);
    bf16* MK = (bf16*)(ws + WS_MK); bf16* MVT = (bf16*)(ws + WS_MVT); bf16* MEMH = (bf16*)(ws + WS_MEMH);
    bf16* WMEMT = (bf16*)(ws + WS_WMEMT); bf16* WOUTT = (bf16*)(ws + WS_WOUTT); bf16* WINT = (bf16*)(ws + WS_WINT);
    unsigned* LIST = (unsigned*)(ws + WS_LIST); f32x2_t* MLB = (f32x2_t*)(ws + WS_ML);
    bf16* H = (bf16*)(ws + WS_H); bf16* Y = (bf16*)(ws + WS_Y); bf16* Z = (bf16*)(ws + WS_Z); bf16* VT = (bf16*)(ws + WS_VT); bf16* OP = (bf16*)(ws + WS_OP);

    {
        LAS float* scr = (LAS float*)(lds + wave * 16384);
        constexpr int I_IN = (DM / 64) * (DIN / 32), I_OUT = (DM / 64) * (DM / 32), I_MEM = (DM / 64) * (1024 / 32), I_POOL = 4 * 2 * 4;
        constexpr int NIT = I_IN + I_OUT + I_MEM + I_POOL;
        for (int it = gw; it < NIT; it += NGW) {
            int q = it;
            if (q < I_IN) { transpose_item(p.w_in, DM, DIN, WINT, scr, q, lane); continue; } q -= I_IN;
            if (q < I_OUT) { transpose_item(p.w_out, DM, DM, WOUTT, scr, q, lane); continue; } q -= I_OUT;
            if (q < I_MEM) { transpose_item(p.w_mem_kv, DM, 1024, WMEMT, scr, q, lane); continue; } q -= I_MEM;
            { const int g = q >> 3; transpose_item(p.w_pool + g * 16384, 128, 128, WPT + g * 16384, scr, q & 7, lane); }
        }
        for (int m = gw; m < NTOK + BATCH * MEML; m += NGW) {
            if (m < NTOK) rms_row_bf16(p.x + (size_t)m * DM, p.norm_g, H + (size_t)m * DM, lane);
            else { const int mm = m - NTOK; rms_row_bf16(p.mem + (size_t)mm * DM, p.mem_norm_g, MEMH + (size_t)mm * DM, lane); }
        }
        if (bx == 0) gcount[tid] = 0u;
    }
    grid.sync();

    {
        pg8::Gemm g{H, WINT, NTOK, DIN, DM}; pg8::StaticOrder S; S.init(NTOK, DIN, G, bx);
        EpiZ E{Z, DIN};
        pg8::gemm_phase<EpiZ, pg8::StaticOrder, true, true>(lds, g, S, E);
    }
    xcd_barrier(bar);

    {
        for (int tt = gw; tt < 32 * 64; tt += NGW) {
            const int tr = tt >> 6, tc = tt & 63, row = lane & 15, quad = lane >> 4;
            const bf16* ap = MEMH + (size_t)(16 * tr + row) * DM + quad * 8;
            const bf16* bp = WMEMT + (size_t)(16 * tc + row) * DM + quad * 8;
            f32x4 acc = {0.f, 0.f, 0.f, 0.f};
#pragma unroll 8
            for (int k0 = 0; k0 < DM; k0 += 32) {
                const bf16x8 a = *(const bf16x8*)(ap + k0), b = *(const bf16x8*)(bp + k0);
                acc = __builtin_amdgcn_mfma_f32_16x16x32_bf16(a, b, acc, 0, 0, 0);
            }
            const int gc = 16 * tc + row, gr0 = 16 * tr + quad * 4;
            if (gc < 512) {
#pragma unroll
                for (int j = 0; j < 4; ++j) MK[(size_t)(gr0 + j) * 512 + gc] = (bf16)(cvtpk(acc[j], 0.f) & 0xffffu);
            } else {
                const int dc = gc - 512, hm = dc >> 7, d = dc & 127, b = gr0 >> 8, m0 = gr0 & 255;
                u32x2 w; w.x = cvtpk(acc[0], acc[1]); w.y = cvtpk(acc[2], acc[3]);
                *(u32x2*)(MVT + ((size_t)((b * NHM + hm) * 128 + d)) * 256 + m0) = w;
            }
        }
        LAS unsigned* vt32 = (LAS unsigned*)lds;
        LAS bf16* vt16 = (LAS bf16*)lds;
        LAS float* ksum = (LAS float*)(lds + 256 * 65 * 4);
        for (int item = bx; item < BATCH * NH * NBLK; item += G) {
            const int j = item & 31, h = (item >> 5) & 7, b = item >> 8;
            const size_t tok0 = (size_t)b * SEQ + (size_t)j * BLK;
            {
                const int c2 = tid & 63, w = tid >> 6;
                float a0 = 0.f, a1 = 0.f;
                const bf16* kp = Z + (tok0 + 32 * w) * DIN + ZK + h * HD + 2 * c2;
#pragma unroll 8
                for (int rr = 0; rr < 32; ++rr) { const unsigned u = *(const unsigned*)(kp + (size_t)rr * DIN); a0 += bflo(u); a1 += bfhi(u); }
                ksum[w * 128 + 2 * c2] = a0; ksum[w * 128 + 2 * c2 + 1] = a1;
            }
#pragma unroll
            for (int it = 0; it < 8; ++it) { const int id = tid + 512 * it, row = id >> 4, ch = id & 15;
                const u32x4 v = *(const u32x4*)(Z + (tok0 + row) * DIN + ZV + h * HD + ch * 8);
                LAS unsigned* d = vt32 + row * 65 + ch * 4; d[0] = v.x; d[1] = v.y; d[2] = v.z; d[3] = v.w; }
            __syncthreads();
            if (tid < 128) {
                float s = 0.f;
#pragma unroll
                for (int w = 0; w < 8; ++w) s += ksum[w * 128 + tid];
                s *= (1.0f / 256.0f);
                const unsigned hi = cvtpk(s, 0.f) & 0xffffu; const float lo = s - __uint_as_float(hi << 16);
                KMH[(size_t)item * 128 + tid] = (bf16)hi; KML[(size_t)item * 128 + tid] = (bf16)(cvtpk(lo, 0.f) & 0xffffu);
            }
#pragma unroll
            for (int it = 0; it < 8; ++it) { const int d = (tid >> 5) + 16 * it, kc = tid & 31;
                unsigned e[8];
#pragma unroll
                for (int jj = 0; jj < 8; ++jj) e[jj] = vt16[(8 * kc + jj) * 130 + d];
                u32x4 o; o.x = e[0] | (e[1] << 16); o.y = e[2] | (e[3] << 16); o.z = e[4] | (e[5] << 16); o.w = e[6] | (e[7] << 16);
                *(u32x4*)(VT + ((size_t)((b * NH + h) * 128 + d)) * SEQ + j * BLK + 8 * kc) = o; }
            __syncthreads();
        }
    }
    xcd_barrier(bar);

    {
        LAS float* gl = (LAS float*)lds;
        LAS unsigned* lcnt = (LAS unsigned*)(lds + 8 * 32 * 33 * 4);
        LAS unsigned* lbase = lcnt + 32;
        for (int item = bx; item < BATCH * NH * NBLK; item += G) {
            const int i = item & 31, h = (item >> 5) & 7, b = item >> 8, bh = item >> 5;
            if (i == 0) continue;
            const int s_q = i * BLK + wave * 32 + r;
            bf16x8 qf[8]; load_q(qf, Z + ((size_t)b * SEQ + s_q) * DIN + ZQ + h * HD, hh);
            f32x16 acc;
#pragma unroll
            for (int ii = 0; ii < 16; ++ii) acc[ii] = 0.f;
            const bf16* kmh = KMH + ((size_t)(bh * 32 + r)) * 128 + 8 * hh; const bf16* kml = KML + ((size_t)(bh * 32 + r)) * 128 + 8 * hh;
#pragma unroll
            for (int d0 = 0; d0 < 8; ++d0) { const bf16x8 a = *(const bf16x8*)(kmh + 16 * d0); acc = MFMA32(a, qf[d0], acc); }
#pragma unroll
            for (int d0 = 0; d0 < 8; ++d0) { const bf16x8 a = *(const bf16x8*)(kml + 16 * d0); acc = MFMA32(a, qf[d0], acc); }
#pragma unroll
            for (int ii = 0; ii < 16; ++ii) gl[(wave * 32 + r) * 33 + crow(ii, hh)] = acc[ii];
            if (tid < 32) lcnt[tid] = 0u;
            __syncthreads();
            int i0 = -1, i1 = -1, i2 = -1; unsigned r0 = 0, r1 = 0, r2 = 0;
            if (hh == 0) {
                float v0 = -INFINITY, v1 = -INFINITY, v2 = -INFINITY;
                const LAS float* gp = gl + (wave * 32 + r) * 33;
                for (int n = 0; n < i; ++n) {
                    const float v = gp[n];
                    if (v > v0) { v2 = v1; i2 = i1; v1 = v0; i1 = i0; v0 = v; i0 = n; }
                    else if (v > v1) { v2 = v1; i2 = i1; v1 = v; i1 = n; }
                    else if (v > v2) { v2 = v; i2 = n; }
                }
                if (i0 >= 0) r0 = atomicAdd((unsigned*)(lcnt + i0), 1u);
                if (i1 >= 0) r1 = atomicAdd((unsigned*)(lcnt + i1), 1u);
                if (i2 >= 0) r2 = atomicAdd((unsigned*)(lcnt + i2), 1u);
            }
            __syncthreads();
            if (tid < i) lbase[tid] = atomicAdd(gcount + bh * 32 + tid, lcnt[tid]);
            __syncthreads();
            if (hh == 0) {
                if (i0 >= 0) LIST[(size_t)(bh * 32 + i0) * 8192 + lbase[i0] + r0] = (unsigned)s_q;
                if (i1 >= 0) LIST[(size_t)(bh * 32 + i1) * 8192 + lbase[i1] + r1] = (unsigned)s_q | (1u << 16);
                if (i2 >= 0) LIST[(size_t)(bh * 32 + i2) * 8192 + lbase[i2] + r2] = (unsigned)s_q | (2u << 16);
            }
            __syncthreads();
        }
        for (int it = gw; it < (NTOK / 32) * 4; it += NGW) {
            const int g = it & 3, tt = it >> 2, T0 = tt * 32, win = 2 << g;
            const int tok = T0 + r, tpos = tok & (SEQ - 1);
            const int cnt = (tpos + 1 < win) ? tpos + 1 : win;
            const float fc = (float)cnt;
            f32x16 acc[4];
#pragma unroll
            for (int dt = 0; dt < 4; ++dt)
#pragma unroll
                for (int ii = 0; ii < 16; ++ii) acc[dt][ii] = 0.f;
            const bf16* up = Z + (size_t)tok * DIN + ZU + g * 128 + 8 * hh;
            const bf16* wp = WPT + (size_t)g * 16384 + (size_t)r * 128 + 8 * hh;
            for (int kk = 0; kk < 8; ++kk) {
                float sm[8];
                const u32x4 u0 = *(const u32x4*)(up + 16 * kk);
                sm[0] = bflo(u0.x); sm[1] = bfhi(u0.x); sm[2] = bflo(u0.y); sm[3] = bfhi(u0.y); sm[4] = bflo(u0.z); sm[5] = bfhi(u0.z); sm[6] = bflo(u0.w); sm[7] = bfhi(u0.w);
                float own[8];
#pragma unroll
                for (int e = 0; e < 8; ++e) own[e] = sm[e];
                for (int w = 1; w < win; ++w) {
                    if (w < cnt) {
                        const u32x4 u = *(const u32x4*)(up + 16 * kk - (size_t)w * DIN);
                        sm[0] += bflo(u.x); sm[1] += bfhi(u.x); sm[2] += bflo(u.y); sm[3] += bfhi(u.y); sm[4] += bflo(u.z); sm[5] += bfhi(u.z); sm[6] += bflo(u.w); sm[7] += bfhi(u.w);
                    }
                }
                u32x4 pa;
                pa.x = cvtpk(sm[0] / fc - own[0], sm[1] / fc - own[1]); pa.y = cvtpk(sm[2] / fc - own[2], sm[3] / fc - own[3]);
                pa.z = cvtpk(sm[4] / fc - own[4], sm[5] / fc - own[5]); pa.w = cvtpk(sm[6] / fc - own[6], sm[7] / fc - own[7]);
                const bf16x8 a = __builtin_bit_cast(bf16x8, pa);
#pragma unroll
                for (int dt = 0; dt < 4; ++dt) { const bf16x8 bb = *(const bf16x8*)(wp + (size_t)dt * 32 * 128 + 16 * kk); acc[dt] = MFMA32(a, bb, acc[dt]); }
            }
#pragma unroll
            for (int dt = 0; dt < 4; ++dt) {
                const int col = g * 128 + 32 * dt + r; const float ps = p.pool_scale[col];
                bf16 gpv[16];
#pragma unroll
                for (int ii = 0; ii < 16; ++ii) gpv[ii] = Z[(size_t)(T0 + crow(ii, hh)) * DIN + ZGP + col];
#pragma unroll
                for (int ii = 0; ii < 16; ++ii) {
                    const size_t t2 = (size_t)(T0 + crow(ii, hh));
                    Y[t2 * DM + 1024 + col] = (bf16)(cvtpk(acc[dt][ii] * ps * silu(bflo((unsigned)gpv[ii])), 0.f) & 0xffffu);
                }
            }
        }
    }
    xcd_barrier(bar);

    {
        LAS unsigned* pre = (LAS unsigned*)(lds + PRE_OFF);
        LAS unsigned* ctr = pre + 528;
        {
            const unsigned nun = ((gcount[tid] + 31u) >> 5) + 8u;
            unsigned v = nun;
#pragma unroll
            for (int off = 1; off < 64; off <<= 1) { const unsigned n = __shfl_up(v, off); if (lane >= off) v += n; }
            if (lane == 63) pre[516 + wave] = v;
            __syncthreads();
            unsigned wb = 0;
            for (int w = 0; w < wave; ++w) wb += pre[516 + w];
            pre[tid + 1] = wb + v; if (tid == 0) pre[0] = 0u;
            __syncthreads();
        }
        const unsigned TL = (unsigned)__builtin_amdgcn_readfirstlane((int)pre[512]), T = TL + 8u * 256u;
        unsigned u = (unsigned)__builtin_amdgcn_readfirstlane((int)(((unsigned long long)T * (unsigned)bx) / (unsigned)G));
        const unsigned u1 = (unsigned)__builtin_amdgcn_readfirstlane((int)(((unsigned long long)T * (unsigned)(bx + 1)) / (unsigned)G));
        while (u < u1) {
            int lid; unsigned lstart, lendf;
            if (u >= TL) { const unsigned k = (u - TL) >> 8; lid = 512 + (int)k; lstart = TL + 256u * k; lendf = lstart + 256u; }
            else { int lo = 0, hi2 = 512; while (hi2 - lo > 1) { const int mid = (lo + hi2) >> 1; if ((unsigned)__builtin_amdgcn_readfirstlane((int)pre[mid]) <= u) lo = mid; else hi2 = mid; } lid = lo;
                   lstart = (unsigned)__builtin_amdgcn_readfirstlane((int)pre[lid]); lendf = (unsigned)__builtin_amdgcn_readfirstlane((int)pre[lid + 1]); }
            const unsigned lend = lendf < u1 ? lendf : u1;
            const bool ismem = lid >= 512;
            const int b = ismem ? ((lid - 512) >> 2) : (lid >> 8), h = ismem ? ((lid - 512) & 3) : ((lid >> 5) & 7), jblk = lid & 31;
            __syncthreads();
            if (ismem) load_kv(lds, MK + (size_t)(b * MEML) * 512 + h * HD, 512, MVT + (size_t)((b * NHM + h) * 128) * 256, 256, tid);
            else load_kv(lds, Z + ((size_t)b * SEQ + (size_t)jblk * BLK) * DIN + ZK + h * HD, DIN, VT + (size_t)((b * NH + h) * 128) * SEQ + jblk * BLK, SEQ, tid);
            if (tid == 0) *ctr = u;
            __syncthreads();
            const unsigned cnt = ismem ? 0u : (unsigned)__builtin_amdgcn_readfirstlane((int)gcount[lid]);
            const unsigned ng = (cnt + 31u) >> 5;
            for (;;) {
                unsigned my = 0;
                if (lane == 0) my = atomicAdd((unsigned*)ctr, 1u);
                my = (unsigned)__builtin_amdgcn_readfirstlane((int)my);
                if (my >= lend) break;
                const unsigned ui = my - lstart;
                int s_q, slot = 3, qloc = 0; bool valid = true, causal = false;
                if (ismem) s_q = (int)ui * 32 + r;
                else if (ui < ng) {
                    unsigned e_i = ui * 32u + (unsigned)r; valid = e_i < cnt; if (!valid) e_i = cnt - 1u;
                    const unsigned e = LIST[(size_t)lid * 8192 + e_i];
                    s_q = (int)(e & 0xffffu); slot = (int)(e >> 16);
                } else { const int qt = 7 - (int)(ui - ng); s_q = jblk * BLK + qt * 32 + r; qloc = qt * 32 + r; causal = true; }
                const size_t tok = (size_t)b * SEQ + s_q;
                bf16x8 qf[8]; load_q(qf, Z + tok * DIN + (ismem ? ZQM : ZQ) + h * HD, hh);
                f32x16 o[4]; float m2, l;
                attn_core2(lds, qf, causal, qloc, r, hh, o, m2, l);
                const float inv = 1.0f / l;
                if (ismem) {
                    const bf16* gp = Z + tok * DIN + ZGM + h * HD + 4 * hh;
#pragma unroll
                    for (int dt = 0; dt < 4; ++dt) {
                        u32x2 gv[4];
#pragma unroll
                        for (int g4 = 0; g4 < 4; ++g4) gv[g4] = *(const u32x2*)(gp + 32 * dt + 8 * g4);
#pragma unroll
                        for (int g4 = 0; g4 < 4; ++g4) {
                            o[dt][4 * g4] *= silu(bflo(gv[g4].x)); o[dt][4 * g4 + 1] *= silu(bfhi(gv[g4].x)); o[dt][4 * g4 + 2] *= silu(bflo(gv[g4].y)); o[dt][4 * g4 + 3] *= silu(bfhi(gv[g4].y)); }
                    }
                }
                bf16* rowp = ismem ? (Y + tok * DM + 1536 + h * HD) : (OP + (((size_t)slot * NTOK + tok) * NH + h) * HD);
                store_row_bf16(rowp, o, inv, hh, valid);
                if (!ismem && valid && hh == 0) { f32x2_t ml = {m2, l}; MLB[((size_t)slot * NTOK + tok) * NH + h] = ml; }
            }
            u = lend;
        }
        __syncthreads();
    }
    xcd_barrier(bar);

    for (int it = bx; it < NTOK / 4; it += G) {
        int tid5 = threadIdx.x; asm volatile("" : "+v"(tid5));
        const size_t tok = (size_t)4 * it + (tid5 >> 7); const int c = tid5 & 127, h = c >> 4;
        const int blk = (int)(tok & (SEQ - 1)) >> 8, nv = blk < 3 ? blk : 3;
        f32x2_t ml[4]; u32x4 pv[4];
#pragma unroll
        for (int k = 0; k < 4; ++k) { ml[k] = MLB[((size_t)k * NTOK + tok) * NH + h]; pv[k] = *(const u32x4*)(OP + ((size_t)k * NTOK + tok) * (NH * HD) + c * 8); }
        const u32x4 gv = *(const u32x4*)(Z + tok * DIN + ZGA + c * 8);
        float M = ml[3].x;
#pragma unroll
        for (int k = 0; k < 3; ++k) if (k < nv) M = fmaxf(M, ml[k].x);
        float wk[4], L = 0.f;
#pragma unroll
        for (int k = 0; k < 4; ++k) { wk[k] = (k == 3 || k < nv) ? ml[k].y * __builtin_amdgcn_exp2f(ml[k].x - M) : 0.f; L += wk[k]; }
        const float inv = 1.0f / L;
        float acc[8];
#pragma unroll
        for (int e = 0; e < 8; ++e) acc[e] = 0.f;
#pragma unroll
        for (int k = 0; k < 4; ++k) if (k == 3 || k < nv) {
            acc[0] += wk[k] * bflo(pv[k].x); acc[1] += wk[k] * bfhi(pv[k].x); acc[2] += wk[k] * bflo(pv[k].y); acc[3] += wk[k] * bfhi(pv[k].y);
            acc[4] += wk[k] * bflo(pv[k].z); acc[5] += wk[k] * bfhi(pv[k].z); acc[6] += wk[k] * bflo(pv[k].w); acc[7] += wk[k] * bfhi(pv[k].w);
        }
        u32x4 w;
        w.x = cvtpk(acc[0] * inv * silu(bflo(gv.x)), acc[1] * inv * silu(bfhi(gv.x))); w.y = cvtpk(acc[2] * inv * silu(bflo(gv.y)), acc[3] * inv * silu(bfhi(gv.y)));
        w.z = cvtpk(acc[4] * inv * silu(bflo(gv.z)), acc[5] * inv * silu(bfhi(gv.z))); w.w = cvtpk(acc[6] * inv * silu(bflo(gv.w)), acc[7] * inv * silu(bfhi(gv.w)));
        *(u32x4*)(Y + tok * DM + c * 8) = w;
    }
    xcd_barrier(bar);

    {
        pg8::Gemm g{Y, WOUTT, NTOK, DM, DM}; pg8::StaticOrder S; S.init(NTOK, DM, G, bx);
        EpiResF32 E{p.x, p.out, DM};
        pg8::gemm_phase<EpiResF32, pg8::StaticOrder, true, true>(lds, g, S, E);
    }
    xcd_barrier(bar);

    { int lane7 = threadIdx.x & 63; asm volatile("" : "+v"(lane7));
      for (int m = gw; m < NTOK; m += NGW) rms_row_f32(p.out + (size_t)m * DM, p.final_g, lane7); }
}

extern "C" void kernel_launch(void* const* d_in, const int* in_sizes, int n_in, void* d_out, int out_size, void* d_ws, size_t ws_size, hipStream_t stream) {
    static int grid = 0;
    if (grid == 0) {
        if (n_in != 10 || in_sizes[0] != NTOK * DM || out_size != NTOK * DM || ws_size < WS_END) {
            fprintf(stderr, "kernel_launch: unexpected shapes (n_in %d, in0 %d, out %d, ws %zu)\n", n_in, n_in > 0 ? in_sizes[0] : -1, out_size, ws_size); grid = -1; return; }
        int dev = 0, cus = 0, per_cu = 0;
        hipGetDevice(&dev); hipDeviceGetAttribute(&cus, hipDeviceAttributeMultiprocessorCount, dev);
        if (hipFuncSetAttribute((const void*)hybrid_fwd, hipFuncAttributeMaxDynamicSharedMemorySize, LDS_BYTES) != hipSuccess) { fprintf(stderr, "kernel_launch: hipFuncSetAttribute failed\n"); grid = -1; return; }
        if (hipOccupancyMaxActiveBlocksPerMultiprocessor(&per_cu, (const void*)hybrid_fwd, 512, LDS_BYTES) != hipSuccess || per_cu < 1) { fprintf(stderr, "kernel_launch: occupancy query says %d\n", per_cu); per_cu = 1; }
        (void)hipGetLastError();
        grid = cus;
    }
    if (grid < 0) return;
    Params p{};
    p.x = (const float*)d_in[0]; p.mem = (const float*)d_in[1]; p.norm_g = (const float*)d_in[2]; p.mem_norm_g = (const float*)d_in[3];
    p.w_in = (const float*)d_in[4]; p.w_mem_kv = (const float*)d_in[5]; p.w_pool = (const float*)d_in[6]; p.pool_scale = (const float*)d_in[7];
    p.w_out = (const float*)d_in[8]; p.final_g = (const float*)d_in[9]; p.out = (float*)d_out; p.ws = (unsigned char*)d_ws;
    if (hipMemsetAsync((char*)d_ws + WS_BAR, 0, BAR_BYTES, stream) != hipSuccess) { fprintf(stderr, "memset failed\n"); return; }
    void* args[] = {&p};
    hipError_t e = hipLaunchCooperativeKernel((const void*)hybrid_fwd, dim3(grid), dim3(512), args, LDS_BYTES, stream);
    if (e != hipSuccess) fprintf(stderr, "cooperative launch failed: %s (grid %d)\n", hipGetErrorString(e), grid);
}
```

```cpp
#include <hip/hip_runtime.h>
#include <hip/hip_cooperative_groups.h>
#include <cstdio>
#include <cstdint>
namespace cg = cooperative_groups;
namespace pg8 {
#define PG8_LAS __attribute__((address_space(3)))
typedef unsigned short bf16_t;
typedef short bf16x8 __attribute__((ext_vector_type(8)));
typedef float f32x4 __attribute__((ext_vector_type(4)));
typedef unsigned u32x4 __attribute__((ext_vector_type(4)));
constexpr int BM = 256, BK = 64, HALF = 128, HTB = HALF * BK * 2  , STAGE_BYTES = 8 * HTB, NXCD = 8, WGM = 8;

__host__ __device__ __forceinline__ int lds_byte(int r, int c) { const int st = (r >> 4) * 2 + (c >> 5), rr = r & 15, cc = c & 31, ob = rr * 64 + cc * 2; return st * 1024 + (ob ^ (((ob >> 9) & 1) << 5)); }
__host__ __device__ __forceinline__ void stage_rc(int b, int& R, int& C) { const int st = b / 1024, sb = b % 1024, swz = sb ^ (((sb >> 9) & 1) << 5); R = (st >> 1) * 16 + swz / 64; C = (st & 1) * 32 + (swz % 64) / 2; }
__host__ __device__ __forceinline__ int perm32(int rho) { const int n = rho >> 4, i = rho & 15; return 8 * (i >> 2) + 4 * n + (i & 3); }

struct Unit { int pm, pn; };
struct Gemm { const bf16_t* A; const bf16_t* Bt; int M, N, K; };

struct StaticOrder {
    int nM, nN, nwg, G, c;
    __host__ __device__ void init(int M, int N, int G_, int c_) { nM = M / BM; nN = N / BM; nwg = nM * nN; G = G_; c = c_; }
    __host__ __device__ bool next(int i, Unit& u) const {
        const long L = (long)i * G + c; if (L >= nwg) return false;
        int wgid = (int)L; { const int q = nwg / NXCD, r = nwg % NXCD, xcd = wgid % NXCD, off = wgid / NXCD; wgid = (xcd < r ? xcd * (q + 1) : r * (q + 1) + (xcd - r) * q) + off; }
        const int nig = WGM * nN, gid = wgid / nig, fm = gid * WGM, gsz = (nM - fm) < WGM ? (nM - fm) : WGM;
        u.pm = fm + ((wgid % nig) % gsz); u.pn = (wgid % nig) / gsz; return true;
    }
    __device__ __forceinline__ void a_ready(const Unit&) const {}
    __device__ __forceinline__ void done(const Unit&) const {}
};

__device__ __forceinline__ unsigned cvt_pk_bf16(float lo, float hi) { unsigned r; asm volatile("v_cvt_pk_bf16_f32 %0, %1, %2" : "=v"(r) : "v"(lo), "v"(hi)); return r; }
typedef float f32x2 __attribute__((ext_vector_type(2)));
__device__ __forceinline__ f32x2 gelu_pk(f32x2 v) {
    const f32x2 av = __builtin_elementwise_abs(v), d = av * 0.2316418882f + 1.0f;
    f32x2 t; t.x = __builtin_amdgcn_rcpf(d.x); t.y = __builtin_amdgcn_rcpf(d.y);
    f32x2 q = t * 0.5307027145f + (-0.7265760135f); q = q * t + 0.7107068705f; q = q * t + (-0.142248368f); q = q * t + 0.127414796f; q = q * t;
    const f32x2 s = (v * v) * (-0.72134752044f);
    f32x2 e; e.x = __builtin_amdgcn_exp2f(s.x); e.y = __builtin_amdgcn_exp2f(s.y);
    const f32x2 m = v * (q * e), r = v - m;
    f32x2 o; o.x = v.x < 0.f ? m.x : r.x; o.y = v.y < 0.f ? m.y : r.y; return o;
}

template <int ACT  > struct EpiBf16 {
    static constexpr bool PERM = true, AFTER_DRAIN = false; static_assert(ACT == 0 || ACT == 1, "EpiBf16: ACT is 0 (none) or 1 (gelu_pk)");
    bf16_t* O; int ldc; const float* bias; int split_cols; size_t split_stride; float scale0;
    __device__ __forceinline__ void operator()(const f32x4 (&acc)[2][2][4][2], const Unit& u, int wr, int wc, int fr, int fq) const {
        const int row0 = u.pm * BM + wr * 64 + fr; int colt = u.pn * BM; bf16_t* base = O;
        float sc = 1.f; if (split_cols) { const int t = colt / split_cols; base += (size_t)t * split_stride; colt -= t * split_cols; if (t == 0) sc = scale0; }
        const int col0 = colt + wc * 32 + 8 * fq, bcol0 = u.pn * BM + wc * 32 + 8 * fq;
        f32x4 bv[2][2];
#pragma unroll
        for (int bj = 0; bj < 2; ++bj)
#pragma unroll
            for (int n = 0; n < 2; ++n) bv[bj][n] = bias ? *(const f32x4*)(bias + bcol0 + bj * HALF + 4 * n) : (f32x4){0.f, 0.f, 0.f, 0.f};
#pragma unroll
        for (int ai = 0; ai < 2; ++ai)
#pragma unroll
            for (int m = 0; m < 4; ++m) { bf16_t* rowp = base + (size_t)(row0 + ai * HALF + m * 16) * ldc + col0;
#pragma unroll
                for (int bj = 0; bj < 2; ++bj) { f32x4 v0 = acc[ai][bj][m][0] + bv[bj][0], v1 = acc[ai][bj][m][1] + bv[bj][1];
                    if (ACT == 1) { f32x2 a = gelu_pk((f32x2){v0[0], v0[1]}), b = gelu_pk((f32x2){v0[2], v0[3]}), c = gelu_pk((f32x2){v1[0], v1[1]}), d = gelu_pk((f32x2){v1[2], v1[3]});
                        v0 = (f32x4){a.x, a.y, b.x, b.y}; v1 = (f32x4){c.x, c.y, d.x, d.y}; }
                    v0 = v0 * sc; v1 = v1 * sc; u32x4 w; w.x = cvt_pk_bf16(v0[0], v0[1]); w.y = cvt_pk_bf16(v0[2], v0[3]); w.z = cvt_pk_bf16(v1[0], v1[1]); w.w = cvt_pk_bf16(v1[2], v1[3]);
                    *(u32x4*)(rowp + bj * HALF) = w; } }
    }
};
template <class Epi, class Sched, bool ALIGN_EPI = false, bool SP2 = false>
__device__ __forceinline__ void gemm_phase(PG8_LAS unsigned char* lds, const Gemm g, const Sched& S, const Epi& E, const int wave_in) {
    int tid_ = wave_in * 64 + (int)__builtin_amdgcn_mbcnt_hi(~0u, __builtin_amdgcn_mbcnt_lo(~0u, 0u)); asm volatile("" : "+v"(tid_));
    const int tid = tid_, wid = __builtin_amdgcn_readfirstlane(tid >> 6), lane = tid & 63, wr = wid >> 2, wc = wid & 3, fr = lane & 15, fq = lane >> 4;
    const int K = g.K, nt = K / BK;
    unsigned voffA[2], voffB[2];
#pragma unroll
    for (int i = 0; i < 2; ++i) { int R, C; stage_rc(tid * 16 + i * 8192, R, C); const int Rb = Epi::PERM ? ((R & ~31) + perm32(R & 31)) : R;
        voffA[i] = (unsigned)(R * K + C) * 2u; voffB[i] = (unsigned)(Rb * K + C) * 2u; }
    const size_t kstep = (size_t)(BK * 2);
    const size_t hstep = (size_t)HALF * K * 2;
    const size_t tstep = 2 * hstep;
    const unsigned ldsw = (unsigned)wid * 1024u;
    const int aoff = lds_byte(wr * 64 + fr, fq * 8), boff = lds_byte(wc * 32 + fr, fq * 8);
#define PG8_SA(b, h) (((b) * 2 + (h)) * HTB)
#define PG8_SB(b, h) ((4 + (b) * 2 + (h)) * HTB)
#define PG8_STAGE(bufoff, gbase, voff) do { _Pragma("unroll") for (int _i = 0; _i < 2; ++_i) \
        __builtin_amdgcn_global_load_lds((const unsigned*)((const char*)(gbase) + (voff)[_i]), (PG8_LAS unsigned*)(lds + (bufoff) + ldsw + _i * 8192), 16, 0, 0); } while (0)
#define PG8_LDA(dst, b, h) do { _Pragma("unroll") for (int m = 0; m < 4; ++m) _Pragma("unroll") for (int k = 0; k < 2; ++k) dst[m][k] = *(const PG8_LAS bf16x8*)(lds + PG8_SA(b, h) + aoff + m * 2048 + k * 1024); } while (0)
#define PG8_LDB(dst, b, h) do { _Pragma("unroll") for (int n = 0; n < 2; ++n) _Pragma("unroll") for (int k = 0; k < 2; ++k) dst[n][k] = *(const PG8_LAS bf16x8*)(lds + PG8_SB(b, h) + boff + n * 2048 + k * 1024); } while (0)
#define PG8_MMA(ai, bj, At, Bt) do { __builtin_amdgcn_s_setprio(1); _Pragma("unroll") for (int m = 0; m < 4; ++m) _Pragma("unroll") for (int n = 0; n < 2; ++n) _Pragma("unroll") for (int k = 0; k < 2; ++k) \
        acc[ai][bj][m][n] = __builtin_amdgcn_mfma_f32_16x16x32_bf16(Bt[n][k], At[m][k], acc[ai][bj][m][n], 0, 0, 0); __builtin_amdgcn_s_setprio(0); } while (0)
#define PG8_WAIT_V(n) asm volatile("s_waitcnt vmcnt(" #n ")" ::: "memory")
#define PG8_WAIT_L(n) asm volatile("s_waitcnt lgkmcnt(" #n ")" ::: "memory")
#define PG8_BAR __builtin_amdgcn_s_barrier()
#define PG8_SCHED __builtin_amdgcn_sched_barrier(0)
    Unit cur, nxt; int ui = 0;
    if (!S.next(0, cur)) return;
    f32x4 acc[2][2][4][2];
#pragma unroll
    for (int a = 0; a < 2; ++a)
#pragma unroll
        for (int b = 0; b < 2; ++b)
#pragma unroll
            for (int m = 0; m < 4; ++m)
#pragma unroll
                for (int n = 0; n < 2; ++n) acc[a][b][m][n] = (f32x4){0.f, 0.f, 0.f, 0.f};
    bf16x8 At[4][2], B0[2][2], B1[2][2];
    const char* cA = (const char*)g.A + (size_t)cur.pm * tstep; const char* cB = (const char*)g.Bt + (size_t)cur.pn * tstep;
    S.a_ready(cur);
    if constexpr (SP2) {
        PG8_STAGE(PG8_SB(0, 0), cB, voffB); PG8_STAGE(PG8_SB(0, 1), cB + hstep, voffB); PG8_STAGE(PG8_SA(0, 0), cA, voffA); PG8_STAGE(PG8_SA(0, 1), cA + hstep, voffA);
        if (wr == 1) PG8_BAR;
        PG8_WAIT_V(2); PG8_BAR;
        PG8_STAGE(PG8_SB(1, 0), cB + kstep, voffB); PG8_STAGE(PG8_SA(1, 0), cA + kstep, voffA); PG8_STAGE(PG8_SB(1, 1), cB + hstep + kstep, voffB);
        PG8_WAIT_V(6); PG8_BAR;
    } else {
        PG8_STAGE(PG8_SB(0, 0), cB, voffB); PG8_STAGE(PG8_SA(0, 0), cA, voffA); PG8_STAGE(PG8_SB(0, 1), cB + hstep, voffB); PG8_STAGE(PG8_SA(0, 1), cA + hstep, voffA);
        if (wr == 1) PG8_BAR;
        PG8_WAIT_V(4); PG8_BAR;
        PG8_STAGE(PG8_SB(1, 0), cB + kstep, voffB); PG8_STAGE(PG8_SA(1, 0), cA + kstep, voffA); PG8_STAGE(PG8_SB(1, 1), cB + hstep + kstep, voffB);
        PG8_WAIT_V(6); PG8_BAR;
    }
    for (;;) {
        const bool has_next = S.next(ui + 1, nxt);
        const char* nA = has_next ? (const char*)g.A + (size_t)nxt.pm * tstep : cA; const char* nB = has_next ? (const char*)g.Bt + (size_t)nxt.pn * tstep : cB;
        for (int t = 0; t < nt; t += 2) {
            const bool last = (t == nt - 2);
            const char* a1 = cA + (size_t)(t + 1) * kstep;
            const char* a2 = last ? nA : cA + (size_t)(t + 2) * kstep; const char* b2 = last ? nB : cB + (size_t)(t + 2) * kstep;
            const char* a3 = a2 + kstep; const char* b3 = b2 + kstep;
            if (last && has_next) S.a_ready(nxt);
            if constexpr (SP2) {
            PG8_LDB(B0, 0, 0); PG8_LDB(B1, 0, 1); PG8_SCHED; PG8_LDA(At, 0, 0); PG8_STAGE(PG8_SA(1, 1), a1 + hstep, voffA);
            PG8_WAIT_V(8); PG8_WAIT_L(0); PG8_BAR; PG8_MMA(0, 0, At, B0); PG8_MMA(0, 1, At, B1); PG8_BAR; PG8_SCHED;
            PG8_LDA(At, 0, 1); PG8_STAGE(PG8_SB(0, 0), b2, voffB); PG8_STAGE(PG8_SB(0, 1), b2 + hstep, voffB); PG8_STAGE(PG8_SA(0, 0), a2, voffA);
            PG8_WAIT_V(8); PG8_WAIT_L(0); PG8_BAR; PG8_MMA(1, 0, At, B0); PG8_MMA(1, 1, At, B1); PG8_BAR; PG8_SCHED;
            PG8_LDB(B0, 1, 0); PG8_LDB(B1, 1, 1); PG8_SCHED; PG8_LDA(At, 1, 0); PG8_STAGE(PG8_SA(0, 1), a2 + hstep, voffA);
            PG8_WAIT_V(8); PG8_WAIT_L(0); PG8_BAR; PG8_MMA(0, 0, At, B0); PG8_MMA(0, 1, At, B1); PG8_BAR; PG8_SCHED;
            PG8_LDA(At, 1, 1); PG8_STAGE(PG8_SB(1, 0), b3, voffB); PG8_STAGE(PG8_SB(1, 1), b3 + hstep, voffB); PG8_STAGE(PG8_SA(1, 0), a3, voffA);
            PG8_WAIT_V(8); PG8_WAIT_L(0); PG8_BAR; PG8_MMA(1, 0, At, B0); PG8_MMA(1, 1, At, B1); PG8_BAR; PG8_SCHED;
            } else {
            PG8_LDB(B0, 0, 0); PG8_SCHED; PG8_LDA(At, 0, 0); PG8_STAGE(PG8_SA(1, 1), a1 + hstep, voffA);
            PG8_WAIT_L(8); PG8_BAR; PG8_WAIT_L(0); PG8_MMA(0, 0, At, B0); PG8_BAR; PG8_SCHED;
            PG8_LDB(B1, 0, 1); PG8_STAGE(PG8_SB(0, 0), b2, voffB);
            PG8_BAR; PG8_WAIT_L(0); PG8_MMA(0, 1, At, B1); PG8_BAR;
            PG8_LDA(At, 0, 1); PG8_STAGE(PG8_SA(0, 0), a2, voffA);
            PG8_BAR; PG8_WAIT_L(0); PG8_MMA(1, 0, At, B0); PG8_BAR; PG8_SCHED;
            PG8_STAGE(PG8_SB(0, 1), b2 + hstep, voffB);
            PG8_WAIT_V(6); PG8_BAR; PG8_MMA(1, 1, At, B1); PG8_BAR;
            PG8_LDB(B0, 1, 0); PG8_SCHED; PG8_LDA(At, 1, 0); PG8_STAGE(PG8_SA(0, 1), a2 + hstep, voffA);
            PG8_WAIT_L(8); PG8_BAR; PG8_WAIT_L(0); PG8_MMA(0, 0, At, B0); PG8_BAR; PG8_SCHED;
            PG8_LDB(B1, 1, 1); PG8_STAGE(PG8_SB(1, 0), b3, voffB);
            PG8_BAR; PG8_WAIT_L(0); PG8_MMA(0, 1, At, B1); PG8_BAR;
            PG8_LDA(At, 1, 1); PG8_STAGE(PG8_SA(1, 0), a3, voffA);
            PG8_BAR; PG8_WAIT_L(0); PG8_MMA(1, 0, At, B0); PG8_BAR; PG8_SCHED;
            PG8_STAGE(PG8_SB(1, 1), b3 + hstep, voffB);
            PG8_WAIT_V(6); PG8_BAR; PG8_MMA(1, 1, At, B1); PG8_BAR;
            }
        }
        if constexpr (ALIGN_EPI) { if (wr == 0) PG8_BAR; }
        if constexpr (!Epi::AFTER_DRAIN) { E(acc, cur, wr, wc, fr, fq); S.done(cur); }
        if (!has_next) break;
#pragma unroll
        for (int a = 0; a < 2; ++a)
#pragma unroll
            for (int b = 0; b < 2; ++b)
#pragma unroll
                for (int m = 0; m < 4; ++m)
#pragma unroll
                    for (int n = 0; n < 2; ++n) acc[a][b][m][n] = (f32x4){0.f, 0.f, 0.f, 0.f};
        cur = nxt; cA = nA; cB = nB; ++ui;
        if constexpr (ALIGN_EPI) { if (wr == 1) PG8_BAR; }
    }
    PG8_WAIT_V(0);
    if constexpr (!ALIGN_EPI) { if (wr == 0) PG8_BAR; }
    PG8_BAR;
    if constexpr (Epi::AFTER_DRAIN) { E.fused(acc, cur, wr, wc, fr, fq, lds, wid, lane); S.done(cur); }
#undef PG8_SA
#undef PG8_SB
#undef PG8_STAGE
#undef PG8_LDA
#undef PG8_LDB
#undef PG8_MMA
#undef PG8_WAIT_V
#undef PG8_WAIT_L
#undef PG8_BAR
#undef PG8_SCHED
}
}
#ifndef REP
#define REP -1
#endif
constexpr int BATCH = 2, SEQ = 8192, DM = 2048, NTOK = BATCH * SEQ, DIN = 6144, MEML = 256;
constexpr int NH = 8, HD = 128, NHM = 4, NBLK = 32, BLK = 256;
constexpr int ZQ = 0, ZK = 1024, ZV = 2048, ZGA = 3072, ZU = 4096, ZGP = 4608, ZQM = 5120, ZGM = 5632;
constexpr float EPS = 1e-6f;
constexpr float SM_C = 0.08838834764831845f * 1.4426950408889634f;

constexpr size_t MiB = 1u << 20;
constexpr size_t WS_CNT = 0; constexpr size_t WS_BAR = 524288, BAR_BYTES = 16384;
constexpr int MISC_OFF = 147456 - 64;
constexpr size_t WS_KMH = 1 * MiB, WS_KML = WS_KMH + 131072, WS_WPT = WS_KML + 131072;
constexpr size_t WS_MK = 2 * MiB;
constexpr size_t WS_MVT = 3 * MiB;
constexpr size_t WS_MEMH = 4 * MiB;
constexpr size_t WS_WMEMT = 6 * MiB;
constexpr size_t WS_WOUTT = 10 * MiB;
constexpr size_t WS_WINT = 18 * MiB;
constexpr size_t WS_LIST = 42 * MiB;
constexpr size_t WS_ML = 58 * MiB;
constexpr size_t WS_H = 64 * MiB;
constexpr size_t WS_Y = WS_H;
constexpr size_t WS_Z = 128 * MiB;
constexpr size_t WS_VT = 320 * MiB;
constexpr size_t WS_OP = 352 * MiB;
constexpr size_t WS_END = 480 * MiB;

constexpr int LDS_BYTES = 147456;
constexpr int KL_OFF = 0, KL_STRIDE = 272, VL_OFF = 256 * KL_STRIDE, VL_STRIDE = 528, PRE_OFF = VL_OFF + 128 * VL_STRIDE;
static_assert(PRE_OFF + 532 * 4 <= 147456 - 64, "lds map");

#define LAS __attribute__((address_space(3)))
typedef unsigned short bf16;
typedef short bf16x8 __attribute__((ext_vector_type(8)));
typedef float f32x4 __attribute__((ext_vector_type(4)));
typedef float f32x16 __attribute__((ext_vector_type(16)));
typedef unsigned u32x4 __attribute__((ext_vector_type(4)));
typedef unsigned u32x2 __attribute__((ext_vector_type(2)));
typedef float f32x2_t __attribute__((ext_vector_type(2)));
typedef __bf16 bf16x2_t __attribute__((ext_vector_type(2)));
#define DI __device__ __forceinline__
#define LANEID() ((int)__builtin_amdgcn_mbcnt_hi(~0u, __builtin_amdgcn_mbcnt_lo(~0u, 0u)))
DI unsigned cvtpk(float lo, float hi) { f32x2_t v = {lo, hi}; bf16x2_t b = __builtin_convertvector(v, bf16x2_t); return __builtin_bit_cast(unsigned, b); }
DI float bflo(unsigned u) { return __uint_as_float(u << 16); }
DI float bfhi(unsigned u) { return __uint_as_float(u & 0xffff0000u); }
DI float wave_sum(float v) {
#pragma unroll
    for (int o = 1; o < 64; o <<= 1) v += __shfl_xor(v, o);
    return v;
}
DI int crow(int i, int h) { return (i & 3) + 8 * (i >> 2) + 4 * h; }
DI int pi32(int r) { return (r & ~12) | ((r & 4) << 1) | ((r & 8) >> 1); }
DI float silu(float g) { return g / (1.0f + __expf(-g)); }
#define MFMA32(a, b, c) __builtin_amdgcn_mfma_f32_32x32x16_bf16((a), (b), (c), 0, 0, 0)

struct Params {
    const float *x, *mem, *norm_g, *mem_norm_g, *w_in, *w_mem_kv, *w_pool, *pool_scale, *w_out, *final_g;
    float* out; unsigned char* ws; long long coop_sync;
};

struct EpiResF32 {
    static constexpr bool PERM = false, AFTER_DRAIN = false;
    const float* base; float* out; int ldc;
    __device__ __forceinline__ void operator()(const pg8::f32x4 (&acc)[2][2][4][2], const pg8::Unit& u, int wr, int wc, int fr, int fq) const {
        const int col0 = u.pn * pg8::BM + wc * 32 + 4 * fq;
#pragma unroll
        for (int ai = 0; ai < 2; ++ai)
#pragma unroll
            for (int m = 0; m < 4; ++m) {
                const size_t off = (size_t)(u.pm * pg8::BM + ai * pg8::HALF + wr * 64 + m * 16 + fr) * ldc + col0;
#pragma unroll
                for (int bj = 0; bj < 2; ++bj)
#pragma unroll
                    for (int n = 0; n < 2; ++n) {
                        const pg8::f32x4 b = *(const pg8::f32x4*)(base + off + bj * pg8::HALF + n * 16);
                        *(pg8::f32x4*)(out + off + bj * pg8::HALF + n * 16) = acc[ai][bj][m][n] + b;
                    }
            }
    }
};
struct EpiZ {
    static constexpr bool PERM = true, AFTER_DRAIN = false;
    bf16* O; int ldc;
    __device__ __forceinline__ void operator()(const pg8::f32x4 (&acc)[2][2][4][2], const pg8::Unit& u, int wr, int wc, int fr, int fq) const {
        const int row0 = u.pm * pg8::BM + wr * 64 + fr; const int col0 = u.pn * pg8::BM + wc * 32 + 8 * fq;
#pragma unroll
        for (int ai = 0; ai < 2; ++ai)
#pragma unroll
            for (int m = 0; m < 4; ++m) { bf16* rowp = O + (size_t)(row0 + ai * pg8::HALF + m * 16) * ldc + col0;
#pragma unroll
                for (int bj = 0; bj < 2; ++bj) { const pg8::f32x4 v0 = acc[ai][bj][m][0], v1 = acc[ai][bj][m][1];
                    u32x4 w; w.x = cvtpk(v0[0], v0[1]); w.y = cvtpk(v0[2], v0[3]); w.z = cvtpk(v1[0], v1[1]); w.w = cvtpk(v1[2], v1[3]);
                    *(u32x4*)(rowp + bj * pg8::HALF) = w; } }
    }
};

DI void transpose_item(const float* W, int K, int N, bf16* WT, LAS float* scr, int item, int lane) {
    const int nblk = N / 32, kb = item / nblk, nb = item % nblk, k0 = 64 * kb, n0 = 32 * nb;
#pragma unroll 8
    for (int i = 0; i < 32; ++i) { const int kk = 2 * i + (lane >> 5); scr[kk * 33 + (lane & 31)] = W[(size_t)(k0 + kk) * N + n0 + (lane & 31)]; }
    __builtin_amdgcn_fence(__ATOMIC_RELEASE, "wavefront"); asm volatile("s_waitcnt lgkmcnt(0)" ::: "memory");
    const int c = lane & 7;
#pragma unroll
    for (int j = 0; j < 4; ++j) { const int n = (lane >> 3) + 8 * j; const LAS float* s = scr + (8 * c) * 33 + n;
        u32x4 o; o.x = cvtpk(s[0 * 33], s[1 * 33]); o.y = cvtpk(s[2 * 33], s[3 * 33]); o.z = cvtpk(s[4 * 33], s[5 * 33]); o.w = cvtpk(s[6 * 33], s[7 * 33]);
        *(u32x4*)(WT + (size_t)(n0 + n) * K + k0 + 8 * c) = o; }
    asm volatile("s_waitcnt lgkmcnt(0)" ::: "memory");
}
DI void rms_row_bf16(const float* xrow, const float* g, bf16* orow, int lane) {
    const f32x4* xr = (const f32x4*)xrow + lane; const f32x4* gr = (const f32x4*)g + lane;
    f32x4 v[8]; float s = 0.f;
#pragma unroll
    for (int j = 0; j < 8; ++j) { v[j] = xr[64 * j]; s += (v[j].x * v[j].x + v[j].y * v[j].y) + (v[j].z * v[j].z + v[j].w * v[j].w); }
    const float rstd = 1.0f / sqrtf(wave_sum(s) * (1.f / DM) + EPS);
    u32x2* o8 = (u32x2*)orow + lane;
#pragma unroll
    for (int j = 0; j < 8; ++j) { const f32x4 gg = gr[64 * j]; u32x2 w; w.x = cvtpk(v[j].x * rstd * gg.x, v[j].y * rstd * gg.y); w.y = cvtpk(v[j].z * rstd * gg.z, v[j].w * rstd * gg.w); o8[64 * j] = w; }
}
DI void rms_row_f32(float* row, const float* g, int lane) {
    f32x4* xr = (f32x4*)row + lane; const f32x4* gr = (const f32x4*)g + lane;
    f32x4 v[8]; float s = 0.f;
#pragma unroll
    for (int j = 0; j < 8; ++j) { v[j] = xr[64 * j]; s += (v[j].x * v[j].x + v[j].y * v[j].y) + (v[j].z * v[j].z + v[j].w * v[j].w); }
    const float rstd = 1.0f / sqrtf(wave_sum(s) * (1.f / DM) + EPS);
#pragma unroll
    for (int j = 0; j < 8; ++j) { const f32x4 gg = gr[64 * j]; xr[64 * j] = v[j] * rstd * gg; }
}

DI void attn_core(const LAS unsigned char* lds, const bf16x8 (&qf)[8], int ntiles, bool causal, int qlocal, int r, int hh, f32x16 (&o)[4], float& m, float& l) {
    m = -1e30f; l = 0.f;
#pragma unroll
    for (int dt = 0; dt < 4; ++dt)
#pragma unroll
        for (int i = 0; i < 16; ++i) o[dt][i] = 0.f;
    const LAS unsigned char* kbase = lds + KL_OFF + pi32(r) * KL_STRIDE + 16 * hh;
    const LAS unsigned char* vbase = lds + VL_OFF + r * VL_STRIDE + 16 * hh;
    for (int kt = 0; kt < ntiles; ++kt) {
        f32x16 s;
#pragma unroll
        for (int i = 0; i < 16; ++i) s[i] = 0.f;
        const LAS unsigned char* kp = kbase + kt * 32 * KL_STRIDE;
#pragma unroll
        for (int d0 = 0; d0 < 8; ++d0) { const bf16x8 kf = *(const LAS bf16x8*)(kp + 32 * d0); s = MFMA32(kf, qf[d0], s); }
        if (causal) {
#pragma unroll
            for (int i = 0; i < 16; ++i) { const int kl = 32 * kt + 16 * (i >> 3) + 8 * hh + (i & 7); if (kl > qlocal) s[i] = -INFINITY; }
        }
        float mx = s[0];
#pragma unroll
        for (int i = 1; i < 16; ++i) mx = fmaxf(mx, s[i]);
        mx = fmaxf(mx, __shfl_xor(mx, 32));
        const float mn = fmaxf(m, mx);
        const float alpha = __builtin_amdgcn_exp2f((m - mn) * SM_C);
        const float mnc = mn * SM_C;
        float ps = 0.f;
#pragma unroll
        for (int i = 0; i < 16; ++i) { s[i] = __builtin_amdgcn_exp2f(s[i] * SM_C - mnc); ps += s[i]; }
        l = l * alpha + ps; m = mn;
#pragma unroll
        for (int dt = 0; dt < 4; ++dt)
#pragma unroll
            for (int i = 0; i < 16; ++i) o[dt][i] *= alpha;
        u32x4 p0, p1;
        p0.x = cvtpk(s[0], s[1]); p0.y = cvtpk(s[2], s[3]); p0.z = cvtpk(s[4], s[5]); p0.w = cvtpk(s[6], s[7]);
        p1.x = cvtpk(s[8], s[9]); p1.y = cvtpk(s[10], s[11]); p1.z = cvtpk(s[12], s[13]); p1.w = cvtpk(s[14], s[15]);
        const bf16x8 pb0 = __builtin_bit_cast(bf16x8, p0), pb1 = __builtin_bit_cast(bf16x8, p1);
        const LAS unsigned char* vp = vbase + kt * 64;
#pragma unroll
        for (int dt = 0; dt < 4; ++dt) {
            const bf16x8 v0 = *(const LAS bf16x8*)(vp + dt * 32 * VL_STRIDE);
            const bf16x8 v1 = *(const LAS bf16x8*)(vp + dt * 32 * VL_STRIDE + 32);
            o[dt] = MFMA32(v0, pb0, o[dt]);
            o[dt] = MFMA32(v1, pb1, o[dt]);
        }
    }
}
#define SB() __builtin_amdgcn_sched_barrier(0)
DI void ldk8(bf16x8 (&kf)[8], const LAS unsigned char* kp) {
#pragma unroll
    for (int d0 = 0; d0 < 8; ++d0) kf[d0] = *(const LAS bf16x8*)(kp + 32 * d0);
}
DI void ldv8(bf16x8 (&vf)[8], const LAS unsigned char* vp) {
#pragma unroll
    for (int dt = 0; dt < 4; ++dt) { vf[2 * dt] = *(const LAS bf16x8*)(vp + dt * 32 * VL_STRIDE); vf[2 * dt + 1] = *(const LAS bf16x8*)(vp + dt * 32 * VL_STRIDE + 32); }
}
DI void qk_half(f32x16 (&s)[4], const LAS unsigned char* kp, const bf16x8 (&qf)[8]) {
    bf16x8 kf[8];
    ldk8(kf, kp); SB();
#pragma unroll
    for (int t = 0; t < 4; ++t) {
        f32x16 a;
#pragma unroll
        for (int i = 0; i < 16; ++i) a[i] = 0.f;
#pragma unroll
        for (int d0 = 0; d0 < 8; ++d0) {
            a = MFMA32(kf[d0], qf[d0], a);
            if (t < 3) kf[d0] = *(const LAS bf16x8*)(kp + (t + 1) * 32 * KL_STRIDE + 32 * d0);
            SB();
        }
        s[t] = a;
    }
}
DI void pv_half(f32x16 (&o)[4], const LAS unsigned char* vp, const u32x4 (&p)[4][2]) {
    bf16x8 vf[8];
    ldv8(vf, vp); SB();
#pragma unroll
    for (int t = 0; t < 4; ++t) {
#pragma unroll
        for (int j = 0; j < 8; ++j) {
            o[j >> 1] = MFMA32(vf[j], __builtin_bit_cast(bf16x8, p[t][j & 1]), o[j >> 1]);
            if (t < 3) vf[j] = *(const LAS bf16x8*)(vp + (t + 1) * 64 + (j >> 1) * 32 * VL_STRIDE + (j & 1) * 32);
            SB();
        }
    }
}
DI float half_max(f32x16 (&s)[4], bool causal, int qt, float limf, int tbase) {
    if (causal) {
#pragma unroll
        for (int t = 0; t < 4; ++t) {
            if (tbase + t > qt) {
#pragma unroll
                for (int i = 0; i < 16; ++i) s[t][i] = -1e30f;
            } else if (tbase + t == qt) {
#pragma unroll
                for (int i = 0; i < 16; ++i) { const float c = (float)(16 * (i >> 3) + (i & 7)); s[t][i] = __builtin_fmaf(fminf(limf - c, 0.f), 1e30f, s[t][i]); }
            }
        }
    }
    float mx = s[0][0];
#pragma unroll
    for (int t = 0; t < 4; ++t)
#pragma unroll
        for (int i = 0; i < 16; ++i) mx = fmaxf(mx, s[t][i]);
    return fmaxf(mx, __shfl_xor(mx, 32));
}
DI float half_exp(const f32x16 (&s)[4], float mc, u32x4 (&p)[4][2]) {
    float ls = 0.f;
#pragma unroll
    for (int t = 0; t < 4; ++t) {
        float e[16];
#pragma unroll
        for (int i = 0; i < 16; ++i) { e[i] = __builtin_amdgcn_exp2f(s[t][i] * SM_C - mc); ls += e[i]; }
        p[t][0].x = cvtpk(e[0], e[1]); p[t][0].y = cvtpk(e[2], e[3]); p[t][0].z = cvtpk(e[4], e[5]); p[t][0].w = cvtpk(e[6], e[7]);
        p[t][1].x = cvtpk(e[8], e[9]); p[t][1].y = cvtpk(e[10], e[11]); p[t][1].z = cvtpk(e[12], e[13]); p[t][1].w = cvtpk(e[14], e[15]);
    }
    return ls;
}
DI void core_qk(const LAS unsigned char* lds, const bf16x8 (&qf)[8], bool causal, int qt, int nhalf, int r, int hh, u32x4 (&pA)[4][2], u32x4 (&pB)[4][2], float& fA, float& lsum, float& m2) {
    const LAS unsigned char* kbase = lds + KL_OFF + pi32(r) * KL_STRIDE + 16 * hh;
    const float limf = (float)(r - 8 * hh);
    float mA, lA, lB = 0.f, M;
    fA = 1.f;
    {
        f32x16 s[4];
        qk_half(s, kbase, qf);
        mA = half_max(s, causal, qt, limf, 0);
        lA = half_exp(s, mA * SM_C, pA);
    }
    M = mA;
    if (nhalf > 1) {
        f32x16 s[4];
        qk_half(s, kbase + 128 * KL_STRIDE, qf);
        const float mB = half_max(s, causal, qt, limf, 4);
        M = fmaxf(mA, mB);
        fA = __builtin_amdgcn_exp2f((mA - M) * SM_C);
        lB = half_exp(s, M * SM_C, pB);
    }
    const float ls = lA * fA + lB;
    lsum = ls + __shfl_xor(ls, 32);
    m2 = M * SM_C;
}
DI void core_pv(const LAS unsigned char* lds, const u32x4 (&pA)[4][2], const u32x4 (&pB)[4][2], float fA, int nhalf, int r, int hh, f32x16 (&o)[4]) {
    const LAS unsigned char* vbase = lds + VL_OFF + r * VL_STRIDE + 16 * hh;
#pragma unroll
    for (int dt = 0; dt < 4; ++dt)
#pragma unroll
        for (int i = 0; i < 16; ++i) o[dt][i] = 0.f;
    pv_half(o, vbase, pA);
    if (nhalf > 1) {
#pragma unroll
        for (int dt = 0; dt < 4; ++dt)
#pragma unroll
            for (int i = 0; i < 16; ++i) o[dt][i] *= fA;
        pv_half(o, vbase + 256, pB);
    }
}
DI void store_row_bf16(bf16* rowp, const f32x16 (&o)[4], float sc, int hh, bool pred) {
#pragma unroll
    for (int dt = 0; dt < 4; ++dt)
#pragma unroll
        for (int a = 0; a < 2; ++a) {
            const unsigned xa = cvtpk(o[dt][8 * a] * sc, o[dt][8 * a + 1] * sc), xb = cvtpk(o[dt][8 * a + 2] * sc, o[dt][8 * a + 3] * sc);
            const unsigned ya = cvtpk(o[dt][8 * a + 4] * sc, o[dt][8 * a + 5] * sc), yb = cvtpk(o[dt][8 * a + 6] * sc, o[dt][8 * a + 7] * sc);
            const auto r1 = __builtin_amdgcn_permlane32_swap(xa, ya, false, false);
            const auto r2 = __builtin_amdgcn_permlane32_swap(xb, yb, false, false);
            u32x4 w; w.x = r1[0]; w.y = r2[0]; w.z = r1[1]; w.w = r2[1];
            if (pred) *(u32x4*)(rowp + 32 * dt + 16 * a + 8 * hh) = w;
        }
}
DI void load_kv(LAS unsigned char* lds, const bf16* Kg, size_t kstride, const bf16* Vg, size_t vstride, int tid_in) {
    int tid = tid_in; asm volatile("" : "+v"(tid));
#pragma unroll
    for (int it = 0; it < 8; ++it) { const int id = tid + 512 * it, row = id >> 4, ch = id & 15;
        const u32x4 v = *(const u32x4*)(Kg + (size_t)row * kstride + ch * 8); *(LAS u32x4*)(lds + KL_OFF + row * KL_STRIDE + ch * 16) = v; }
#pragma unroll
    for (int it = 0; it < 8; ++it) { const int id = tid + 512 * it, d = id >> 5, ch = id & 31;
        const u32x4 v = *(const u32x4*)(Vg + (size_t)d * vstride + ch * 8); *(LAS u32x4*)(lds + VL_OFF + d * VL_STRIDE + ch * 16) = v; }
}
DI void load_q(bf16x8 (&qf)[8], const bf16* qrow, int hh) {
#pragma unroll
    for (int d0 = 0; d0 < 8; ++d0) qf[d0] = *(const bf16x8*)(qrow + 16 * d0 + 8 * hh);
}

typedef __attribute__((address_space(1))) unsigned gu32;
#define XB_TMO      128
#define XB_XCNT(j)  (256  + 64 * (j))
#define XB_XSUB(j)  (1280 + 64 * (j))
#define XB_XGEN(j)  (2304 + 64 * (j))
#define XB_TOP      3328
#define XB_TOPGEN   3392
#define XCD_BAR_WORDS 3456
#define XB_SPIN_CAP (1u << 18)

__device__ __forceinline__ unsigned xb_ld(unsigned* p)              { return __hip_atomic_load(p, __ATOMIC_RELAXED, __HIP_MEMORY_SCOPE_AGENT); }
__device__ __forceinline__ unsigned xb_add(unsigned* p, unsigned v) { return __hip_atomic_fetch_add(p, v, __ATOMIC_RELAXED, __HIP_MEMORY_SCOPE_AGENT); }
__device__ __forceinline__ unsigned xb_xcc_id() { return (unsigned)__builtin_amdgcn_s_getreg((3 << 11) | 20) & 0xFu; }
#define XB_SPIN(cond, bar) do { unsigned _sp = 0; while (cond) { __builtin_amdgcn_s_sleep(1); \
    if ((++_sp & 255u) == 0u) { if (xb_ld(&(bar)[XB_TMO])) break; if (_sp > XB_SPIN_CAP) { atomicAdd(&(bar)[XB_TMO], 1u); break; } } } } while (0)

struct XcdBarrier {
    unsigned* bar; unsigned x; unsigned w;
    volatile LAS unsigned* st;
};

__device__ __forceinline__ XcdBarrier xcd_barrier_post(unsigned* bar, volatile LAS unsigned* st) {
    XcdBarrier b; b.bar = bar; b.x = xb_xcc_id(); b.st = st; b.w = (unsigned)__builtin_amdgcn_readfirstlane((int)(threadIdx.x >> 6));
    if (threadIdx.x == 0) (void)xb_add(&bar[XB_XCNT(b.x)], 1u);
    return b;
}
__device__ __forceinline__ void xcd_barrier_complete(unsigned* bar, unsigned x, unsigned& nloc, unsigned& nx) {
    const unsigned G = gridDim.x * gridDim.y * gridDim.z;
    unsigned sum, cnt, mine, sp = 0u;
    for (;;) {
        sum = 0u; cnt = 0u; mine = 0u;
#pragma unroll
        for (unsigned j = 0; j < 16; ++j) { const unsigned c = xb_ld(&bar[XB_XCNT(j)]); sum += c; cnt += (c > 0u) ? 1u : 0u; mine = (j == x) ? c : mine; }
        if (sum == G) break;
        __builtin_amdgcn_s_sleep(1);
        if ((++sp & 255u) == 0u) { if (xb_ld(&bar[XB_TMO])) break; if (sp > XB_SPIN_CAP) { atomicAdd(&bar[XB_TMO], 1u); break; } }
    }
    nloc = mine > 0u ? mine : 1u; nx = cnt > 0u ? cnt : 1u;
}

__device__ __forceinline__ void xcd_barrier(const XcdBarrier& b) {
    asm volatile("s_waitcnt vmcnt(0)" ::: "memory");
    __syncthreads();
    if (b.w == 0u && LANEID() == 0) {
        unsigned* bar = b.bar;
        __builtin_amdgcn_s_waitcnt(0);
        unsigned nloc = b.st[0], nx = b.st[1];
        if (nloc == 0u) { xcd_barrier_complete(bar, b.x, nloc, nx); b.st[0] = nloc; b.st[1] = nx; }
        const unsigned old = xb_add(&bar[XB_XSUB(b.x)], 1u);
        const unsigned gen = old / nloc;
        if (old + 1u == (gen + 1u) * nloc) {
            __builtin_amdgcn_fence(__ATOMIC_RELEASE, "agent");
            asm volatile("s_waitcnt vmcnt(0)" ::: "memory");
            const unsigned og = xb_add(&bar[XB_TOP], 1u);
            const unsigned tg = og / nx;
            if (og + 1u == (tg + 1u) * nx) xb_add(&bar[XB_TOPGEN], 1u);
            else XB_SPIN(xb_ld(&bar[XB_TOPGEN]) == tg, bar);
            __builtin_amdgcn_fence(__ATOMIC_ACQUIRE, "agent");
            xb_add(&bar[XB_XGEN(b.x)], 1u);
            asm volatile("s_waitcnt vmcnt(0)" ::: "memory");
        } else {
            XB_SPIN(xb_ld(&bar[XB_XGEN(b.x)]) == gen, bar);
            __builtin_amdgcn_fence(__ATOMIC_ACQUIRE, "agent");
            asm volatile("s_waitcnt vmcnt(0)" ::: "memory");
        }
    }
    __syncthreads();
}

__global__ void __launch_bounds__(512, 2) hybrid_fwd(Params p) {
    extern __shared__ __attribute__((aligned(16))) unsigned char lds_raw[];
    LAS unsigned char* lds = (LAS unsigned char*)lds_raw;
    cg::grid_group grid = cg::this_grid();
    const int wave = __builtin_amdgcn_readfirstlane((int)(threadIdx.x >> 6));
#define IDS() int lane = LANEID(); asm volatile("" : "+v"(lane)); const int tid = wave * 64 + lane, r = lane & 31, hh = lane >> 5; (void)tid; (void)r; (void)hh
    const int tid0 = threadIdx.x;
    const int G = gridDim.x, bx = blockIdx.x;
    const int gw = bx * 8 + wave, NGW = G * 8;
    unsigned char* ws = p.ws;
    if (tid0 < 16) ((LAS unsigned*)(lds + MISC_OFF))[tid0] = 0u;
    __syncthreads();
    XcdBarrier bar = xcd_barrier_post((unsigned*)(ws + WS_BAR), (volatile LAS unsigned*)(lds + MISC_OFF));
    unsigned* gcount = (unsigned*)(ws + WS_CNT);
    bf16* KMH = (bf16*)(ws + WS_KMH); bf16* KML = (bf16*)(ws + WS_KML); bf16* WPT = (bf16*)(ws + WS_WPT);
    bf16* MK = (bf16*)(ws + WS_MK); bf16* MVT = (bf16*)(ws + WS_MVT); bf16* MEMH = (bf16*)(ws + WS_MEMH);
    bf16* WMEMT = (bf16*)(ws + WS_WMEMT); bf16* WOUTT = (bf16*)(ws + WS_WOUTT); bf16* WINT = (bf16*)(ws + WS_WINT);
    unsigned* LIST = (unsigned*)(ws + WS_LIST); f32x2_t* MLB = (f32x2_t*)(ws + WS_ML);
    bf16* H = (bf16*)(ws + WS_H); bf16* Y = (bf16*)(ws + WS_Y); bf16* Z = (bf16*)(ws + WS_Z); bf16* VT = (bf16*)(ws + WS_VT); bf16* OP = (bf16*)(ws + WS_OP);

    {
        IDS();
        LAS float* scr = (LAS float*)(lds + wave * 16384);
        constexpr int I_IN = (DM / 64) * (DIN / 32), I_OUT = (DM / 64) * (DM / 32), I_MEM = (DM / 64) * (1024 / 32), I_POOL = 4 * 2 * 4;
        constexpr int NIT = I_IN + I_OUT + I_MEM + I_POOL;
        for (int it = gw; it < NIT; it += NGW) {
            int q = it;
            if (q < I_IN) { transpose_item(p.w_in, DM, DIN, WINT, scr, q, lane); continue; } q -= I_IN;
            if (q < I_OUT) { transpose_item(p.w_out, DM, DM, WOUTT, scr, q, lane); continue; } q -= I_OUT;
            if (q < I_MEM) { transpose_item(p.w_mem_kv, DM, 1024, WMEMT, scr, q, lane); continue; } q -= I_MEM;
            { const int g = q >> 3; transpose_item(p.w_pool + g * 16384, 128, 128, WPT + g * 16384, scr, q & 7, lane); }
        }
        for (int m = gw; m < NTOK + BATCH * MEML; m += NGW) {
            if (m < NTOK) rms_row_bf16(p.x + (size_t)m * DM, p.norm_g, H + (size_t)m * DM, lane);
            else { const int mm = m - NTOK; rms_row_bf16(p.mem + (size_t)mm * DM, p.mem_norm_g, MEMH + (size_t)mm * DM, lane); }
        }
        if (bx == 0) gcount[tid] = 0u;
    }
    if (p.coop_sync != 0) grid.sync();
    xcd_barrier(bar);

    {
        pg8::Gemm g{H, WINT, NTOK, DIN, DM}; pg8::StaticOrder S; S.init(NTOK, DIN, G, bx);
        EpiZ E{Z, DIN};
        pg8::gemm_phase<EpiZ, pg8::StaticOrder, true, true>(lds, g, S, E, wave);
    }
    xcd_barrier(bar);

    {
        IDS();
        for (int tt = gw; tt < 32 * 64; tt += NGW) {
            const int tr = tt >> 6, tc = tt & 63, row = lane & 15, quad = lane >> 4;
            const bf16* ap = MEMH + (size_t)(16 * tr + row) * DM + quad * 8;
            const bf16* bp = WMEMT + (size_t)(16 * tc + row) * DM + quad * 8;
            f32x4 acc = {0.f, 0.f, 0.f, 0.f};
#pragma unroll 8
            for (int k0 = 0; k0 < DM; k0 += 32) {
                const bf16x8 a = *(const bf16x8*)(ap + k0), b = *(const bf16x8*)(bp + k0);
                acc = __builtin_amdgcn_mfma_f32_16x16x32_bf16(a, b, acc, 0, 0, 0);
            }
            const int gc = 16 * tc + row, gr0 = 16 * tr + quad * 4;
            if (gc < 512) {
#pragma unroll
                for (int j = 0; j < 4; ++j) MK[(size_t)(gr0 + j) * 512 + gc] = (bf16)(cvtpk(acc[j], 0.f) & 0xffffu);
            } else {
                const int dc = gc - 512, hm = dc >> 7, d = dc & 127, b = gr0 >> 8, m0 = gr0 & 255;
                u32x2 w; w.x = cvtpk(acc[0], acc[1]); w.y = cvtpk(acc[2], acc[3]);
                *(u32x2*)(MVT + ((size_t)((b * NHM + hm) * 128 + d)) * 256 + m0) = w;
            }
        }
        LAS unsigned* vt32 = (LAS unsigned*)lds;
        LAS bf16* vt16 = (LAS bf16*)lds;
        LAS float* ksum = (LAS float*)(lds + 256 * 65 * 4);
        for (int item = bx; item < BATCH * NH * NBLK; item += G) {
            const int j = item & 31, h = (item >> 5) & 7, b = item >> 8;
            const size_t tok0 = (size_t)b * SEQ + (size_t)j * BLK;
            {
                const int c2 = tid & 63, w = tid >> 6;
                float a0 = 0.f, a1 = 0.f;
                const bf16* kp = Z + (tok0 + 32 * w) * DIN + ZK + h * HD + 2 * c2;
#pragma unroll 8
                for (int rr = 0; rr < 32; ++rr) { const unsigned u = *(const unsigned*)(kp + (size_t)rr * DIN); a0 += bflo(u); a1 += bfhi(u); }
                ksum[w * 128 + 2 * c2] = a0; ksum[w * 128 + 2 * c2 + 1] = a1;
            }
#pragma unroll
            for (int it = 0; it < 8; ++it) { const int id = tid + 512 * it, row = id >> 4, ch = id & 15;
                const u32x4 v = *(const u32x4*)(Z + (tok0 + row) * DIN + ZV + h * HD + ch * 8);
                LAS unsigned* d = vt32 + row * 65 + ch * 4; d[0] = v.x; d[1] = v.y; d[2] = v.z; d[3] = v.w; }
            __syncthreads();
            if (tid < 128) {
                float s = 0.f;
#pragma unroll
                for (int w = 0; w < 8; ++w) s += ksum[w * 128 + tid];
                s *= (1.0f / 256.0f);
                const unsigned hi = cvtpk(s, 0.f) & 0xffffu; const float lo = s - __uint_as_float(hi << 16);
                KMH[(size_t)item * 128 + tid] = (bf16)hi; KML[(size_t)item * 128 + tid] = (bf16)(cvtpk(lo, 0.f) & 0xffffu);
            }
#pragma unroll
            for (int it = 0; it < 8; ++it) { const int d = (tid >> 5) + 16 * it, kc = tid & 31;
                unsigned e[8];
#pragma unroll
                for (int jj = 0; jj < 8; ++jj) e[jj] = vt16[(8 * kc + jj) * 130 + d];
                u32x4 o; o.x = e[0] | (e[1] << 16); o.y = e[2] | (e[3] << 16); o.z = e[4] | (e[5] << 16); o.w = e[6] | (e[7] << 16);
                *(u32x4*)(VT + ((size_t)((b * NH + h) * 128 + d)) * SEQ + j * BLK + 8 * kc) = o; }
            __syncthreads();
        }
    }
    xcd_barrier(bar);

    {
        IDS();
        LAS float* gl = (LAS float*)lds;
        LAS unsigned* lcnt = (LAS unsigned*)(lds + 8 * 32 * 33 * 4);
        LAS unsigned* lbase = lcnt + 32;
        for (int item = bx; item < BATCH * NH * NBLK; item += G) {
            const int i = item & 31, h = (item >> 5) & 7, b = item >> 8, bh = item >> 5;
            if (i == 0) continue;
            const int s_q = i * BLK + wave * 32 + r;
            bf16x8 qf[8]; load_q(qf, Z + ((size_t)b * SEQ + s_q) * DIN + ZQ + h * HD, hh);
            f32x16 acc;
#pragma unroll
            for (int ii = 0; ii < 16; ++ii) acc[ii] = 0.f;
            const bf16* kmh = KMH + ((size_t)(bh * 32 + r)) * 128 + 8 * hh; const bf16* kml = KML + ((size_t)(bh * 32 + r)) * 128 + 8 * hh;
#pragma unroll
            for (int d0 = 0; d0 < 8; ++d0) { const bf16x8 a = *(const bf16x8*)(kmh + 16 * d0); acc = MFMA32(a, qf[d0], acc); }
#pragma unroll
            for (int d0 = 0; d0 < 8; ++d0) { const bf16x8 a = *(const bf16x8*)(kml + 16 * d0); acc = MFMA32(a, qf[d0], acc); }
#pragma unroll
            for (int ii = 0; ii < 16; ++ii) gl[(wave * 32 + r) * 33 + crow(ii, hh)] = acc[ii];
            if (tid < 32) lcnt[tid] = 0u;
            __syncthreads();
            int i0 = -1, i1 = -1, i2 = -1; unsigned r0 = 0, r1 = 0, r2 = 0;
            if (hh == 0) {
                float v0 = -INFINITY, v1 = -INFINITY, v2 = -INFINITY;
                const LAS float* gp = gl + (wave * 32 + r) * 33;
                for (int n = 0; n < i; ++n) {
                    const float v = gp[n];
                    if (v > v0) { v2 = v1; i2 = i1; v1 = v0; i1 = i0; v0 = v; i0 = n; }
                    else if (v > v1) { v2 = v1; i2 = i1; v1 = v; i1 = n; }
                    else if (v > v2) { v2 = v; i2 = n; }
                }
                if (i0 >= 0) r0 = atomicAdd((unsigned*)(lcnt + i0), 1u);
                if (i1 >= 0) r1 = atomicAdd((unsigned*)(lcnt + i1), 1u);
                if (i2 >= 0) r2 = atomicAdd((unsigned*)(lcnt + i2), 1u);
            }
            __syncthreads();
            if (tid < i) lbase[tid] = atomicAdd(gcount + bh * 32 + tid, lcnt[tid]);
            __syncthreads();
            if (hh == 0) {
                if (i0 >= 0) LIST[(size_t)(bh * 32 + i0) * 8192 + lbase[i0] + r0] = (unsigned)s_q;
                if (i1 >= 0) LIST[(size_t)(bh * 32 + i1) * 8192 + lbase[i1] + r1] = (unsigned)s_q | (1u << 16);
                if (i2 >= 0) LIST[(size_t)(bh * 32 + i2) * 8192 + lbase[i2] + r2] = (unsigned)s_q | (2u << 16);
            }
            __syncthreads();
        }
        for (int rep = 0; rep < (REP == 3 ? 2 : 1); ++rep)
        for (int it = gw; it < (NTOK / 32) * 4; it += NGW) {
            const int g = it & 3, tt = it >> 2, T0 = tt * 32, win = 2 << g;
            const int tok = T0 + r, tpos = tok & (SEQ - 1);
            const int cnt = (tpos + 1 < win) ? tpos + 1 : win;
            const float fc = (float)cnt;
            f32x16 acc[4];
#pragma unroll
            for (int dt = 0; dt < 4; ++dt)
#pragma unroll
                for (int ii = 0; ii < 16; ++ii) acc[dt][ii] = 0.f;
            const bf16* up = Z + (size_t)tok * DIN + ZU + g * 128 + 8 * hh;
            const bf16* wp = WPT + (size_t)g * 16384 + (size_t)r * 128 + 8 * hh;
            for (int kk = 0; kk < 8; ++kk) {
                float sm[8];
                const u32x4 u0 = *(const u32x4*)(up + 16 * kk);
                sm[0] = bflo(u0.x); sm[1] = bfhi(u0.x); sm[2] = bflo(u0.y); sm[3] = bfhi(u0.y); sm[4] = bflo(u0.z); sm[5] = bfhi(u0.z); sm[6] = bflo(u0.w); sm[7] = bfhi(u0.w);
                float own[8];
#pragma unroll
                for (int e = 0; e < 8; ++e) own[e] = sm[e];
                for (int w = 1; w < win; ++w) {
                    if (w < cnt) {
                        const u32x4 u = *(const u32x4*)(up + 16 * kk - (size_t)w * DIN);
                        sm[0] += bflo(u.x); sm[1] += bfhi(u.x); sm[2] += bflo(u.y); sm[3] += bfhi(u.y); sm[4] += bflo(u.z); sm[5] += bfhi(u.z); sm[6] += bflo(u.w); sm[7] += bfhi(u.w);
                    }
                }
                u32x4 pa;
                pa.x = cvtpk(sm[0] / fc - own[0], sm[1] / fc - own[1]); pa.y = cvtpk(sm[2] / fc - own[2], sm[3] / fc - own[3]);
                pa.z = cvtpk(sm[4] / fc - own[4], sm[5] / fc - own[5]); pa.w = cvtpk(sm[6] / fc - own[6], sm[7] / fc - own[7]);
                const bf16x8 a = __builtin_bit_cast(bf16x8, pa);
#pragma unroll
                for (int dt = 0; dt < 4; ++dt) { const bf16x8 bb = *(const bf16x8*)(wp + (size_t)dt * 32 * 128 + 16 * kk); acc[dt] = MFMA32(a, bb, acc[dt]); }
            }
#pragma unroll
            for (int dt = 0; dt < 4; ++dt) {
                const int col = g * 128 + 32 * dt + r; const float ps = p.pool_scale[col];
                bf16 gpv[16];
#pragma unroll
                for (int ii = 0; ii < 16; ++ii) gpv[ii] = Z[(size_t)(T0 + crow(ii, hh)) * DIN + ZGP + col];
#pragma unroll
                for (int ii = 0; ii < 16; ++ii) {
                    const size_t t2 = (size_t)(T0 + crow(ii, hh));
                    Y[t2 * DM + 1024 + col] = (bf16)(cvtpk(acc[dt][ii] * ps * silu(bflo((unsigned)gpv[ii])), 0.f) & 0xffffu);
                }
            }
        }
    }
    xcd_barrier(bar);

    for (int rep = 0; rep < (REP == 4 ? 2 : 1); ++rep) {
        IDS();
        LAS unsigned* pre = (LAS unsigned*)(lds + PRE_OFF);
        LAS unsigned* ctr = pre + 528;
        {
            const unsigned nun = ((gcount[tid] + 31u) >> 5) + 8u;
            unsigned v = nun;
#pragma unroll
            for (int off = 1; off < 64; off <<= 1) { const unsigned n = __shfl_up(v, off); if (lane >= off) v += n; }
            if (lane == 63) pre[516 + wave] = v;
            __syncthreads();
            unsigned wb = 0;
            for (int w = 0; w < wave; ++w) wb += pre[516 + w];
            pre[tid + 1] = wb + v; if (tid == 0) pre[0] = 0u;
            __syncthreads();
        }
        const unsigned TL = (unsigned)__builtin_amdgcn_readfirstlane((int)pre[512]), T = TL + 8u * 256u;
        unsigned u = (unsigned)__builtin_amdgcn_readfirstlane((int)(((unsigned long long)T * (unsigned)bx) / (unsigned)G));
        const unsigned u1 = (unsigned)__builtin_amdgcn_readfirstlane((int)(((unsigned long long)T * (unsigned)(bx + 1)) / (unsigned)G));
        while (u < u1) {
            int lid; unsigned lstart, lendf;
            if (u >= TL) { const unsigned k = (u - TL) >> 8; lid = 512 + (int)k; lstart = TL + 256u * k; lendf = lstart + 256u; }
            else { int lo = 0, hi2 = 512; while (hi2 - lo > 1) { const int mid = (lo + hi2) >> 1; if ((unsigned)__builtin_amdgcn_readfirstlane((int)pre[mid]) <= u) lo = mid; else hi2 = mid; } lid = lo;
                   lstart = (unsigned)__builtin_amdgcn_readfirstlane((int)pre[lid]); lendf = (unsigned)__builtin_amdgcn_readfirstlane((int)pre[lid + 1]); }
            const unsigned lend = lendf < u1 ? lendf : u1;
            const bool ismem = lid >= 512;
            const int b = ismem ? ((lid - 512) >> 2) : (lid >> 8), h = ismem ? ((lid - 512) & 3) : ((lid >> 5) & 7), jblk = lid & 31;
            __syncthreads();
            if (ismem) load_kv(lds, MK + (size_t)(b * MEML) * 512 + h * HD, 512, MVT + (size_t)((b * NHM + h) * 128) * 256, 256, tid);
            else load_kv(lds, Z + ((size_t)b * SEQ + (size_t)jblk * BLK) * DIN + ZK + h * HD, DIN, VT + (size_t)((b * NH + h) * 128) * SEQ + jblk * BLK, SEQ, tid);
            if (tid == 0) *ctr = u;
            __syncthreads();
            const unsigned cnt = ismem ? 0u : (unsigned)__builtin_amdgcn_readfirstlane((int)gcount[lid]);
            const unsigned ng = (cnt + 31u) >> 5;
#define GRAB(dst) do { unsigned g_ = 0; if (LANEID() == 0) g_ = atomicAdd((unsigned*)ctr, 1u); dst = (unsigned)__builtin_amdgcn_readfirstlane((int)g_); } while (0)
#define DECODE(my_, einfo_, vld_, qt_, nhalf_, causal_) do { const unsigned ui_ = (my_) - lstart; int ln_ = LANEID(); asm volatile("" : "+v"(ln_)); const int r_ = ln_ & 31; \
                qt_ = 0; nhalf_ = 2; causal_ = false; vld_ = 1u; \
                if (ismem) einfo_ = (ui_ * 32u + (unsigned)r_) | (3u << 16); \
                else if (ui_ < ng) { unsigned e_i = ui_ * 32u + (unsigned)r_; vld_ = e_i < cnt ? 1u : 0u; if (!vld_) e_i = cnt - 1u; einfo_ = LIST[(size_t)lid * 8192 + e_i]; } \
                else { qt_ = 7 - (int)(ui_ - ng); einfo_ = (unsigned)(jblk * BLK + qt_ * 32 + r_) | (3u << 16); causal_ = true; nhalf_ = qt_ >= 4 ? 2 : 1; } } while (0)
#define LOADQ(einfo_) do { int ln_ = LANEID(); asm volatile("" : "+v"(ln_)); load_q(qf, Z + ((size_t)b * SEQ + ((einfo_) & 0xffffu)) * DIN + (ismem ? ZQM : ZQ) + h * HD, ln_ >> 5); } while (0)
            unsigned my; GRAB(my);
            bool have = my < lend;
            unsigned einfo = 0, vld = 1u; int qt = 0, nhalf = 2; bool causal = false;
            bf16x8 qf[8];
            if (have) { DECODE(my, einfo, vld, qt, nhalf, causal); LOADQ(einfo); }
            while (have) {
                unsigned myn; GRAB(myn);
                const bool haven = myn < lend;
                unsigned einfon = 0, vldn = 1u; int qtn = 0, nhalfn = 2; bool causaln = false;
                if (haven) DECODE(myn, einfon, vldn, qtn, nhalfn, causaln);
                u32x4 pA[4][2], pB[4][2]; float fA, l, m2;
                { int ln = LANEID(); asm volatile("" : "+v"(ln)); core_qk(lds, qf, causal, qt, nhalf, ln & 31, ln >> 5, pA, pB, fA, l, m2); }
                if (haven) LOADQ(einfon);
                f32x16 o[4];
                { int ln = LANEID(); asm volatile("" : "+v"(ln)); core_pv(lds, pA, pB, fA, nhalf, ln & 31, ln >> 5, o); }
                {
                    asm volatile("" : "+v"(einfo));
                    int ln2 = LANEID(); asm volatile("" : "+v"(ln2)); const int hh2 = ln2 >> 5;
                    const size_t tok = (size_t)b * SEQ + (einfo & 0xffffu); const int slot = (int)((einfo >> 16) & 3u); const bool valid = vld != 0u;
                    const float inv = 1.0f / l;
                    if (ismem) {
                        const bf16* gp = Z + tok * DIN + ZGM + h * HD + 4 * hh2;
#pragma unroll
                        for (int dt = 0; dt < 4; ++dt) {
                            u32x2 gv[4];
#pragma unroll
                            for (int g4 = 0; g4 < 4; ++g4) gv[g4] = *(const u32x2*)(gp + 32 * dt + 8 * g4);
#pragma unroll
                            for (int g4 = 0; g4 < 4; ++g4) {
                                o[dt][4 * g4] *= silu(bflo(gv[g4].x)); o[dt][4 * g4 + 1] *= silu(bfhi(gv[g4].x)); o[dt][4 * g4 + 2] *= silu(bflo(gv[g4].y)); o[dt][4 * g4 + 3] *= silu(bfhi(gv[g4].y)); }
                        }
                    }
                    bf16* rowp = ismem ? (Y + tok * DM + 1536 + h * HD) : (OP + (((size_t)slot * NTOK + tok) * NH + h) * HD);
                    store_row_bf16(rowp, o, inv, hh2, valid);
                    if (!ismem && valid && hh2 == 0) { f32x2_t ml = {m2, l}; MLB[((size_t)slot * NTOK + tok) * NH + h] = ml; }
                }
                einfo = einfon; vld = vldn; qt = qtn; nhalf = nhalfn; causal = causaln; have = haven;
            }
#undef GRAB
#undef DECODE
#undef LOADQ
            u = lend;
        }
        __syncthreads();
    }
    xcd_barrier(bar);

    for (int rep = 0; rep < (REP == 5 ? 2 : 1); ++rep)
    for (int it = bx; it < NTOK / 4; it += G) {
        int tid5 = wave * 64 + LANEID(); asm volatile("" : "+v"(tid5));
        const size_t tok = (size_t)4 * it + (tid5 >> 7); const int c = tid5 & 127, h = c >> 4;
        const int blk = (int)(tok & (SEQ - 1)) >> 8, nv = blk < 3 ? blk : 3;
        f32x2_t ml[4]; u32x4 pv[4];
#pragma unroll
        for (int k = 0; k < 4; ++k) { ml[k] = MLB[((size_t)k * NTOK + tok) * NH + h]; pv[k] = *(const u32x4*)(OP + ((size_t)k * NTOK + tok) * (NH * HD) + c * 8); }
        const u32x4 gv = *(const u32x4*)(Z + tok * DIN + ZGA + c * 8);
        float M = ml[3].x;
#pragma unroll
        for (int k = 0; k < 3; ++k) if (k < nv) M = fmaxf(M, ml[k].x);
        float wk[4], L = 0.f;
#pragma unroll
        for (int k = 0; k < 4; ++k) { wk[k] = (k == 3 || k < nv) ? ml[k].y * __builtin_amdgcn_exp2f(ml[k].x - M) : 0.f; L += wk[k]; }
        const float inv = 1.0f / L;
        float acc[8];
#pragma unroll
        for (int e = 0; e < 8; ++e) acc[e] = 0.f;
#pragma unroll
        for (int k = 0; k < 4; ++k) if (k == 3 || k < nv) {
            acc[0] += wk[k] * bflo(pv[k].x); acc[1] += wk[k] * bfhi(pv[k].x); acc[2] += wk[k] * bflo(pv[k].y); acc[3] += wk[k] * bfhi(pv[k].y);
            acc[4] += wk[k] * bflo(pv[k].z); acc[5] += wk[k] * bfhi(pv[k].z); acc[6] += wk[k] * bflo(pv[k].w); acc[7] += wk[k] * bfhi(pv[k].w);
        }
        u32x4 w;
        w.x = cvtpk(acc[0] * inv * silu(bflo(gv.x)), acc[1] * inv * silu(bfhi(gv.x))); w.y = cvtpk(acc[2] * inv * silu(bflo(gv.y)), acc[3] * inv * silu(bfhi(gv.y)));
        w.z = cvtpk(acc[4] * inv * silu(bflo(gv.z)), acc[5] * inv * silu(bfhi(gv.z))); w.w = cvtpk(acc[6] * inv * silu(bflo(gv.w)), acc[7] * inv * silu(bfhi(gv.w)));
        *(u32x4*)(Y + tok * DM + c * 8) = w;
    }
    xcd_barrier(bar);

    for (int rep = 0; rep < (REP == 6 ? 2 : 1); ++rep) {
        pg8::Gemm g{Y, WOUTT, NTOK, DM, DM}; pg8::StaticOrder S; S.init(NTOK, DM, G, bx);
        EpiResF32 E{p.x, p.out, DM};
        pg8::gemm_phase<EpiResF32, pg8::StaticOrder, true, true>(lds, g, S, E, wave);
    }
    xcd_barrier(bar);

    { int lane7 = LANEID(); asm volatile("" : "+v"(lane7));
      for (int m = gw; m < NTOK; m += NGW) rms_row_f32(p.out + (size_t)m * DM, p.final_g, lane7); }
}

extern "C" void kernel_launch(void* const* d_in, const int* in_sizes, int n_in, void* d_out, int out_size, void* d_ws, size_t ws_size, hipStream_t stream) {
    static int grid = 0;
    if (grid == 0) {
        if (n_in != 10 || in_sizes[0] != NTOK * DM || out_size != NTOK * DM || ws_size < WS_END) {
            fprintf(stderr, "kernel_launch: unexpected shapes (n_in %d, in0 %d, out %d, ws %zu)\n", n_in, n_in > 0 ? in_sizes[0] : -1, out_size, ws_size); grid = -1; return; }
        int dev = 0, cus = 0, per_cu = 0;
        hipGetDevice(&dev); hipDeviceGetAttribute(&cus, hipDeviceAttributeMultiprocessorCount, dev);
        if (hipFuncSetAttribute((const void*)hybrid_fwd, hipFuncAttributeMaxDynamicSharedMemorySize, LDS_BYTES) != hipSuccess) { fprintf(stderr, "kernel_launch: hipFuncSetAttribute failed\n"); grid = -1; return; }
        if (hipOccupancyMaxActiveBlocksPerMultiprocessor(&per_cu, (const void*)hybrid_fwd, 512, LDS_BYTES) != hipSuccess || per_cu < 1) { fprintf(stderr, "kernel_launch: occupancy query says %d\n", per_cu); per_cu = 1; }
        (void)hipGetLastError();
        grid = cus;
    }
    if (grid < 0) return;
    Params p{};
    p.x = (const float*)d_in[0]; p.mem = (const float*)d_in[1]; p.norm_g = (const float*)d_in[2]; p.mem_norm_g = (const float*)d_in[3];
    p.w_in = (const float*)d_in[4]; p.w_mem_kv = (const float*)d_in[5]; p.w_pool = (const float*)d_in[6]; p.pool_scale = (const float*)d_in[7];
    p.w_out = (const float*)d_in[8]; p.final_g = (const float*)d_in[9]; p.out = (float*)d_out; p.ws = (unsigned char*)d_ws;
    if (hipMemsetAsync((char*)d_ws + WS_BAR, 0, BAR_BYTES, stream) != hipSuccess) { fprintf(stderr, "memset failed\n"); return; }
    void* args[] = {&p};
    hipError_t e = hipLaunchCooperativeKernel((const void*)hybrid_fwd, dim3(grid), dim3(512), args, LDS_BYTES, stream);
    if (e != hipSuccess) fprintf(stderr, "cooperative launch failed: %s (grid %d)\n", hipGetErrorString(e), grid);
}
```
